# Optimizing an MI355X kernel written in HIP

```python
import jax, jax.numpy as jnp
from jax import lax
import numpy as np

D_MODEL = 1024
BATCH = 16
SEQ = 256
DEPTH = 2
DEC_BATCH = 4
DEC_SEQ = 4096
PAST_LEN = 256

GRID_W = 64
Q_BLOCK = 128
ROPE_THETA = 10000.0
RMS_EPS = 1e-6
NEG_INF = -1e30
MLA_HEADS = 8
MLA_Q_LORA = 256
MLA_KV_LORA = 256
MLA_NOPE_DIM = 64
MLA_ROPE_DIM = 32
MLA_V_DIM = 64
MLA_QK_DIM = MLA_NOPE_DIM + MLA_ROPE_DIM
MLA_SCALE = MLA_QK_DIM ** -0.5
NA_HEADS = 8
NA_HEAD_DIM = 64
NA_WIN_H = 8
NA_WIN_W = 16
NA_SCALE = NA_HEAD_DIM ** -0.5
W_IN_A = MLA_Q_LORA + MLA_KV_LORA + MLA_ROPE_DIM + 3 * NA_HEADS * NA_HEAD_DIM
W_OUT_A = MLA_HEADS * MLA_V_DIM + NA_HEADS * NA_HEAD_DIM
GQA_HEADS = 8
GQA_KV_HEADS = 2
GQA_HEAD_DIM = 128
GQA_SCALE = GQA_HEAD_DIM ** -0.5
W_IN_C = (GQA_HEADS + 2 * GQA_KV_HEADS) * GQA_HEAD_DIM
W_OUT_C = GQA_HEADS * GQA_HEAD_DIM
D_FF = -(-8 * D_MODEL // (3 * 256)) * 256
N_EVEN = (DEPTH + 1) // 2
N_ODD = DEPTH // 2

kernel_name = "hybrid_mla_natten_gqa_prefix_diffusion_step"


def rms_norm(x, g):
    xf = x.astype(jnp.float32)
    y = xf * lax.rsqrt(jnp.mean(xf * xf, axis=-1, keepdims=True) + RMS_EPS)
    return (y * g.astype(jnp.float32)).astype(x.dtype)


def ada_modulation(cond, w_mod, b_mod):
    m = jax.nn.silu(cond) @ w_mod + b_mod
    return jnp.split(m, 6, axis=-1)


def modulate(h, shift, scale):
    return h * (1.0 + scale) + shift


def axial_rope_tables(n_tokens, rot_dim):
    t = jnp.arange(n_tokens)
    row = (t // GRID_W).astype(jnp.float32)
    col = (t % GRID_W).astype(jnp.float32)
    axis_dim = rot_dim // 2
    inv_freq = ROPE_THETA ** (-jnp.arange(0, axis_dim, 2, dtype=jnp.float32) / axis_dim)
    ang = jnp.concatenate([row[:, None] * inv_freq, col[:, None] * inv_freq], axis=-1)
    return jnp.cos(ang), jnp.sin(ang)


def apply_rope(x, cos, sin):
    half = x.shape[-1] // 2
    xf = x.astype(jnp.float32)
    x1, x2 = xf[..., :half], xf[..., half:]
    c = cos[None, :, None, :]
    s = sin[None, :, None, :]
    return jnp.concatenate([x1 * c - x2 * s, x1 * s + x2 * c], axis=-1).astype(x.dtype)


def attend_blocked(q, k, v, scale):
    b, t, h, dq = q.shape
    hk, dv = k.shape[2], v.shape[-1]
    g = h // hk
    nb = t // Q_BLOCK
    qb = q.reshape(b, nb, Q_BLOCK, hk, g, dq).transpose(1, 0, 2, 3, 4, 5)

    def block(qi):
        s = jnp.einsum('bqkgd,bskd->bkgqs', qi, k).astype(jnp.float32) * scale
        p = jax.nn.softmax(s, axis=-1).astype(v.dtype)
        return jnp.einsum('bkgqs,bskd->bqkgd', p, v)

    o = lax.map(block, qb)
    return o.transpose(1, 0, 2, 3, 4, 5).reshape(b, t, h, dv)


def neighbourhood_attention(q, k, v, k_ctx, v_ctx, rpb):
    b, t, h, d = q.shape
    n_rows = t // GRID_W
    wh = min(NA_WIN_H, n_rows)
    qg = q.reshape(b, n_rows, GRID_W, h, d).transpose(1, 0, 2, 3, 4)
    kg = k.reshape(b, n_rows, GRID_W, h, d)
    vg = v.reshape(b, n_rows, GRID_W, h, d)
    rows = jnp.arange(n_rows)
    row_start = jnp.clip(rows - wh // 2, 0, n_rows - wh)
    cols = jnp.arange(GRID_W)
    col_start = jnp.clip(cols - NA_WIN_W // 2, 0, GRID_W - NA_WIN_W)
    col_mask = (cols[None, :] >= col_start[:, None]) & (cols[None, :] < col_start[:, None] + NA_WIN_W)
    dc_idx = jnp.clip(cols[None, :] - cols[:, None] + NA_WIN_W - 1, 0, 2 * NA_WIN_W - 2)

    def one_row(args):
        q_r, r, rs = args
        k_band = lax.dynamic_slice_in_dim(kg, rs, wh, axis=1)
        v_band = lax.dynamic_slice_in_dim(vg, rs, wh, axis=1)
        dr_idx = rs + jnp.arange(wh) - r + NA_WIN_H - 1
        bias = rpb[:, dr_idx][:, :, dc_idx]
        s_band = jnp.einsum('bqhd,bikhd->bhqik', q_r, k_band).astype(jnp.float32) * NA_SCALE
        s_band = s_band + bias.transpose(0, 2, 1, 3)[None].astype(jnp.float32)
        s_band = jnp.where(col_mask[:, None, :], s_band, NEG_INF)
        s_band = s_band.reshape(b, h, GRID_W, wh * GRID_W)
        s_ctx = jnp.einsum('bqhd,bchd->bhqc', q_r, k_ctx).astype(jnp.float32) * NA_SCALE
        p = jax.nn.softmax(jnp.concatenate([s_band, s_ctx], axis=-1), axis=-1).astype(v.dtype)
        p_band = p[..., :wh * GRID_W].reshape(b, h, GRID_W, wh, GRID_W)
        p_ctx = p[..., wh * GRID_W:]
        return (jnp.einsum('bhqik,bikhd->bqhd', p_band, v_band)
                + jnp.einsum('bhqc,bchd->bqhd', p_ctx, v_ctx))

    o = lax.map(one_row, (qg, rows, row_start))
    return o.transpose(1, 0, 2, 3, 4).reshape(b, t, h, d)


def even_project(h, w_in, q_norm, w_uq, kv_norm, w_ukv):
    b, L, _ = h.shape
    p = h @ w_in
    i0 = MLA_Q_LORA
    i1 = i0 + MLA_KV_LORA
    i2 = i1 + MLA_ROPE_DIM
    na_w = NA_HEADS * NA_HEAD_DIM
    cq, ckv, krope, nq, nk, nv = jnp.split(p, [i0, i1, i2, i2 + na_w, i2 + 2 * na_w], axis=-1)
    q = (rms_norm(cq, q_norm) @ w_uq).reshape(b, L, MLA_HEADS, MLA_QK_DIM)
    ckv = rms_norm(ckv, kv_norm)
    shp = (b, L, NA_HEADS, NA_HEAD_DIM)
    return q, ckv, krope, nq.reshape(shp), nk.reshape(shp), nv.reshape(shp)


def mla_expand(ckv, w_ukv, k_rope):
    b, L, _ = ckv.shape
    kv = (ckv @ w_ukv).reshape(b, L, MLA_HEADS, MLA_NOPE_DIM + MLA_V_DIM)
    k_nope, v = kv[..., :MLA_NOPE_DIM], kv[..., MLA_NOPE_DIM:]
    k_r = jnp.broadcast_to(k_rope[:, :, None, :], (b, L, MLA_HEADS, MLA_ROPE_DIM))
    return jnp.concatenate([k_nope, k_r], axis=-1), v


def even_mixer_context(h, w_in, q_norm, w_uq, kv_norm, w_ukv, w_out):
    b, L, _ = h.shape
    q, ckv, krope, nq, nk, nv = even_project(h, w_in, q_norm, w_uq, kv_norm, w_ukv)
    k, v = mla_expand(ckv, w_ukv, krope)
    a_mla = attend_blocked(q, k, v, MLA_SCALE)
    a_na = attend_blocked(nq, nk, nv, NA_SCALE)
    out = jnp.concatenate([a_mla.reshape(b, L, -1), a_na.reshape(b, L, -1)], axis=-1) @ w_out
    return out, ckv, krope, nk, nv


def even_mixer_latent(h, c_ckv, c_krope, c_nk, c_nv, w_in, q_norm, w_uq, kv_norm, w_ukv, rpb, w_out,
                      cos, sin):
    b, L, _ = h.shape
    q, ckv, krope, nq, nk, nv = even_project(h, w_in, q_norm, w_uq, kv_norm, w_ukv)
    q = jnp.concatenate([q[..., :MLA_NOPE_DIM], apply_rope(q[..., MLA_NOPE_DIM:], cos, sin)], axis=-1)
    krope = apply_rope(krope[:, :, None, :], cos, sin)[:, :, 0, :]
    k_lat, v_lat = mla_expand(ckv, w_ukv, krope)
    k_ctx, v_ctx = mla_expand(c_ckv, w_ukv, c_krope)
    a_mla = attend_blocked(q, jnp.concatenate([k_lat, k_ctx], axis=1),
                           jnp.concatenate([v_lat, v_ctx], axis=1), MLA_SCALE)
    a_na = neighbourhood_attention(nq, nk, nv, c_nk, c_nv, rpb)
    return jnp.concatenate([a_mla.reshape(b, L, -1), a_na.reshape(b, L, -1)], axis=-1) @ w_out


def odd_project(h, w_in, q_norm, k_norm):
    b, L, _ = h.shape
    p = h @ w_in
    q, k, v = jnp.split(p, [GQA_HEADS * GQA_HEAD_DIM, (GQA_HEADS + GQA_KV_HEADS) * GQA_HEAD_DIM], axis=-1)
    q = rms_norm(q.reshape(b, L, GQA_HEADS, GQA_HEAD_DIM), q_norm)
    k = rms_norm(k.reshape(b, L, GQA_KV_HEADS, GQA_HEAD_DIM), k_norm)
    v = v.reshape(b, L, GQA_KV_HEADS, GQA_HEAD_DIM)
    return q, k, v


def odd_mixer_context(h, w_in, q_norm, k_norm, w_out):
    b, L, _ = h.shape
    q, k, v = odd_project(h, w_in, q_norm, k_norm)
    out = attend_blocked(q, k, v, GQA_SCALE).reshape(b, L, -1) @ w_out
    return out, k, v


def odd_mixer_latent(h, c_k, c_v, w_in, q_norm, k_norm, w_out, cos, sin):
    b, L, _ = h.shape
    q, k, v = odd_project(h, w_in, q_norm, k_norm)
    q = apply_rope(q, cos, sin)
    k = apply_rope(k, cos, sin)
    o = attend_blocked(q, jnp.concatenate([k, c_k], axis=1), jnp.concatenate([v, c_v], axis=1), GQA_SCALE)
    return o.reshape(b, L, -1) @ w_out


def swiglu(h, w_in, w_out):
    gate, up = jnp.split(h @ w_in, 2, axis=-1)
    return (jax.nn.silu(gate) * up) @ w_out


def setup_inputs(seed: int = 0) -> dict:
    key = jax.random.key(seed)
    ks = iter(jax.random.split(key, 40))

    def nrm(shape, scale=1.0):
        return jax.random.normal(next(ks), shape, jnp.float32) * scale

    def gain(shape):
        return 1.0 + nrm(shape, 0.05)

    d = D_MODEL
    return {
        "x_prompt": nrm((BATCH, SEQ, d)),
        "x_sample": nrm((DEC_BATCH, DEC_SEQ, d)),
        "cache_mla_ckv": nrm((DEC_BATCH, N_EVEN, PAST_LEN, MLA_KV_LORA)),
        "cache_mla_krope": nrm((DEC_BATCH, N_EVEN, PAST_LEN, MLA_ROPE_DIM)),
        "cache_na_k": nrm((DEC_BATCH, N_EVEN, PAST_LEN, NA_HEADS, NA_HEAD_DIM)),
        "cache_na_v": nrm((DEC_BATCH, N_EVEN, PAST_LEN, NA_HEADS, NA_HEAD_DIM)),
        "cache_gqa_k": nrm((DEC_BATCH, N_ODD, PAST_LEN, GQA_KV_HEADS, GQA_HEAD_DIM)),
        "cache_gqa_v": nrm((DEC_BATCH, N_ODD, PAST_LEN, GQA_KV_HEADS, GQA_HEAD_DIM)),
        "c": nrm((DEC_BATCH, d)),
        "c_ctx": nrm((d,)),
        "w_mod": nrm((DEPTH, d, 6 * d), 0.5 * d ** -0.5),
        "b_mod": nrm((DEPTH, 6 * d), 0.02),
        "norm_mix": gain((DEPTH, d)),
        "norm_ffn": gain((DEPTH, d)),
        "norm_final": gain((d,)),
        "w_in_a": nrm((N_EVEN, d, W_IN_A), d ** -0.5),
        "mla_q_norm": gain((N_EVEN, MLA_Q_LORA)),
        "mla_w_uq": nrm((N_EVEN, MLA_Q_LORA, MLA_HEADS * MLA_QK_DIM), MLA_Q_LORA ** -0.5),
        "mla_kv_norm": gain((N_EVEN, MLA_KV_LORA)),
        "mla_w_ukv": nrm((N_EVEN, MLA_KV_LORA, MLA_HEADS * (MLA_NOPE_DIM + MLA_V_DIM)), MLA_KV_LORA ** -0.5),
        "na_rpb": nrm((N_EVEN, NA_HEADS, 2 * NA_WIN_H - 1, 2 * NA_WIN_W - 1), 0.5),
        "w_out_a": nrm((N_EVEN, W_OUT_A, d), W_OUT_A ** -0.5),
        "w_in_c": nrm((N_ODD, d, W_IN_C), d ** -0.5),
        "gqa_q_norm": gain((N_ODD, GQA_HEAD_DIM)),
        "gqa_k_norm": gain((N_ODD, GQA_HEAD_DIM)),
        "w_out_c": nrm((N_ODD, W_OUT_C, d), W_OUT_C ** -0.5),
        "w_ffn_in": nrm((DEPTH, d, 2 * D_FF), d ** -0.5),
        "w_ffn_out": nrm((DEPTH, D_FF, d), D_FF ** -0.5),
    }


def reference(x_prompt, x_sample, cache_mla_ckv, cache_mla_krope, cache_na_k, cache_na_v, cache_gqa_k,
              cache_gqa_v, c, c_ctx, w_mod, b_mod, norm_mix, norm_ffn, norm_final, w_in_a, mla_q_norm,
              mla_w_uq, mla_kv_norm, mla_w_ukv, na_rpb, w_out_a, w_in_c, gqa_q_norm, gqa_k_norm, w_out_c,
              w_ffn_in, w_ffn_out):
    xp = x_prompt
    xs = x_sample
    n_lat = x_sample.shape[1]
    cos_m, sin_m = axial_rope_tables(n_lat, MLA_ROPE_DIM)
    cos_g, sin_g = axial_rope_tables(n_lat, GQA_HEAD_DIM)
    cond_ctx = c_ctx[None, None, :]
    cond_lat = c[:, None, :]
    st_ckv, st_krope, st_nk, st_nv, st_gk, st_gv = [], [], [], [], [], []

    for l in range(DEPTH):
        sh1_p, sc1_p, g1_p, sh2_p, sc2_p, g2_p = ada_modulation(cond_ctx, w_mod[l], b_mod[l])
        sh1_s, sc1_s, g1_s, sh2_s, sc2_s, g2_s = ada_modulation(cond_lat, w_mod[l], b_mod[l])
        hp = modulate(rms_norm(xp, norm_mix[l]), sh1_p, sc1_p)
        hs = modulate(rms_norm(xs, norm_mix[l]), sh1_s, sc1_s)
        if l % 2 == 0:
            e = l // 2
            out_p, ckv, krope, nk, nv = even_mixer_context(
                hp, w_in_a[e], mla_q_norm[e], mla_w_uq[e], mla_kv_norm[e], mla_w_ukv[e], w_out_a[e])
            st_ckv.append(ckv)
            st_krope.append(krope)
            st_nk.append(nk)
            st_nv.append(nv)
            out_s = even_mixer_latent(
                hs, cache_mla_ckv[:, e], cache_mla_krope[:, e], cache_na_k[:, e], cache_na_v[:, e],
                w_in_a[e], mla_q_norm[e], mla_w_uq[e], mla_kv_norm[e], mla_w_ukv[e], na_rpb[e], w_out_a[e],
                cos_m, sin_m)
        else:
            o = l // 2
            out_p, gk, gv = odd_mixer_context(hp, w_in_c[o], gqa_q_norm[o], gqa_k_norm[o], w_out_c[o])
            st_gk.append(gk)
            st_gv.append(gv)
            out_s = odd_mixer_latent(hs, cache_gqa_k[:, o], cache_gqa_v[:, o], w_in_c[o], gqa_q_norm[o],
                                     gqa_k_norm[o], w_out_c[o], cos_g, sin_g)
        xp = xp + g1_p * out_p
        xs = xs + g1_s * out_s
        hp = modulate(rms_norm(xp, norm_ffn[l]), sh2_p, sc2_p)
        hs = modulate(rms_norm(xs, norm_ffn[l]), sh2_s, sc2_s)
        xp = xp + g2_p * swiglu(hp, w_ffn_in[l], w_ffn_out[l])
        xs = xs + g2_s * swiglu(hs, w_ffn_in[l], w_ffn_out[l])

    y_prompt = rms_norm(xp, norm_final)
    y_sample = rms_norm(xs, norm_final)
    state_mla_ckv = jnp.stack(st_ckv, axis=1)
    state_mla_krope = jnp.stack(st_krope, axis=1)
    state_na_k = jnp.stack(st_nk, axis=1)
    state_na_v = jnp.stack(st_nv, axis=1)
    state_gqa_k = jnp.stack(st_gk, axis=1)
    state_gqa_v = jnp.stack(st_gv, axis=1)
    return (y_prompt, y_sample, state_mla_ckv, state_mla_krope, state_na_k, state_na_v, state_gqa_k, state_gqa_v)
```

```cpp
#include <hip/hip_runtime.h>
#include <hip/hip_cooperative_groups.h>
#include <cstdint>
#include <cstdio>
namespace cg = cooperative_groups;

#define LAS __attribute__((address_space(3)))
typedef unsigned short bf16_t;
typedef short bf16x8 __attribute__((ext_vector_type(8)));
typedef short s16x4 __attribute__((ext_vector_type(4)));
typedef float f32x4 __attribute__((ext_vector_type(4)));
typedef float f32x16 __attribute__((ext_vector_type(16)));
typedef unsigned u32x4 __attribute__((ext_vector_type(4)));
typedef unsigned u32x2 __attribute__((ext_vector_type(2)));
typedef float f32x2_t __attribute__((ext_vector_type(2)));
typedef __bf16 bf16x2_t __attribute__((ext_vector_type(2)));

__device__ __forceinline__ unsigned cvtpk(float lo, float hi) { f32x2_t v = {lo, hi}; bf16x2_t b = __builtin_convertvector(v, bf16x2_t); return __builtin_bit_cast(unsigned, b); }
__device__ __forceinline__ float bf_lo(unsigned u) { return __uint_as_float(u << 16); }
__device__ __forceinline__ float bf_hi(unsigned u) { return __uint_as_float(u & 0xffff0000u); }
__device__ __forceinline__ int lane_now() { int r; asm volatile("v_mbcnt_lo_u32_b32 %0, -1, 0\n\tv_mbcnt_hi_u32_b32 %0, -1, %0" : "=v"(r)); return r; }
__device__ __forceinline__ float wave_sum(float v, int lane) {
#pragma unroll
    for (int o = 32; o >= 1; o >>= 1) v += __builtin_bit_cast(float, __builtin_amdgcn_ds_bpermute((lane ^ o) << 2, __builtin_bit_cast(int, v)));
    return v;
}
__device__ __forceinline__ float half_sum(float v) { auto r = __builtin_amdgcn_permlane32_swap(__float_as_uint(v), __float_as_uint(v), false, false); return __uint_as_float(r[0]) + __uint_as_float(r[1]); }
__device__ __forceinline__ float half_max(float v) { auto r = __builtin_amdgcn_permlane32_swap(__float_as_uint(v), __float_as_uint(v), false, false); return fmaxf(__uint_as_float(r[0]), __uint_as_float(r[1])); }

constexpr int D = 1024, MCTX = 4096, MLAT = 16384, MTOK = 20480, MALL = 21504;
constexpr int DFF = 2816, NINA = 2304, LDP = 2304, NINC = 1536;
constexpr float RMS_EPS = 1e-6f;
constexpr float LOG2E = 1.4426950408889634f;
constexpr size_t MiB = 1u << 20;
constexpr size_t WS_MOD = 0;
constexpr size_t WS_BAR = 512 * 1024;
constexpr size_t WS_COSM = 1 * MiB, WS_SINM = 1 * MiB + 262144, WS_COSG = 2 * MiB, WS_SING = 3 * MiB;
constexpr size_t WS_WINA = 4 * MiB;
constexpr size_t WS_WUQ = WS_WINA + 4718592;
constexpr size_t WS_WUKV = WS_WUQ + 393216;
constexpr size_t WS_WOUTA = WS_WUKV + 524288;
constexpr size_t WS_WF1_0 = WS_WOUTA + 2097152;
constexpr size_t WS_WF2_0 = WS_WF1_0 + 11534336;
constexpr size_t WS_HO = 28 * MiB;
constexpr size_t WS_BIG = 68 * MiB;
constexpr size_t WS_P = WS_BIG;
constexpr size_t WS_QM = WS_P + 99090432;
constexpr size_t WS_KV = WS_QM + 31457280;
constexpr size_t WS_KR = WS_KV + 44040192;
constexpr size_t WS_END0 = WS_KR + 1376256;
constexpr size_t WS_HF = WS_BIG;
constexpr size_t WS_W1 = WS_BIG + 112 * MiB;
constexpr size_t WS_WINC = WS_W1;
constexpr size_t WS_WOUTC = WS_WINC + 3145728;
constexpr size_t WS_WF1_1 = WS_WOUTC + 2097152;
constexpr size_t WS_WF2_1 = WS_WF1_1 + 11534336;
constexpr size_t WS_PART = WS_BIG + 134 * MiB;
constexpr size_t WS_P2 = WS_BIG;
constexpr size_t WS_KG = WS_BIG + 60 * MiB;
constexpr size_t WS_VG = WS_KG + 11010048;
static_assert(WS_WF2_0 + 5767168 <= WS_HO, "w0");
static_assert(WS_END0 <= 256 * MiB, "ws");
static_assert(WS_WF2_1 + 5767168 <= WS_PART && WS_PART + 33554432 <= WS_END0, "w1/part");
constexpr size_t O_Y = 0, O_CKV = 20971520, O_KROPE = 22020096, O_NAK = 22151168, O_NAV = 24248320, O_GK = 26345472, O_GV = 27394048;

constexpr int LDS_BYTES = 147456;
#ifndef DBG_GM
#define DBG_GM 0xff
#endif

namespace pg8 {
constexpr int BM = 256, BK = 64, HALF = 128, HTB = HALF * BK * 2, STAGE_BYTES = 8 * HTB, NXCD = 8, WGM = 8;
__host__ __device__ __forceinline__ int lds_byte(int r, int c) { const int st = (r >> 4) * 2 + (c >> 5), rr = r & 15, cc = c & 31, ob = rr * 64 + cc * 2; return st * 1024 + (ob ^ (((ob >> 9) & 1) << 5)); }
__host__ __device__ __forceinline__ void stage_rc(int b, int& R, int& C) { const int st = b / 1024, sb = b % 1024, swz = sb ^ (((sb >> 9) & 1) << 5); R = (st >> 1) * 16 + swz / 64; C = (st & 1) * 32 + (swz % 64) / 2; }
__host__ __device__ __forceinline__ int perm32(int rho) { const int n = rho >> 4, i = rho & 15; return 8 * (i >> 2) + 4 * n + (i & 3); }
struct Unit { int pm, pn, k0, nt, part; };
struct Gemm { const bf16_t* A; const bf16_t* Bt; int M, N, K, lda, ldb; };
struct StaticOrder {
    int nM, nN, nwg, G, c, K, hybrid;
    __device__ void init(int M, int N, int G_, int c_, int K_ = 0, int hybrid_ = 0) { nM = hybrid_ ? 64 : M / BM; nN = N / BM; nwg = nM * nN; G = G_; c = c_; K = K_; hybrid = hybrid_; }
    __device__ bool next(int i, Unit& u) const {
        long L = (long)i * G + c; u.k0 = 0; u.nt = K / BK; u.part = 0;
        if (hybrid) {
            if (i > 1) return false;
            if (i == 1) { const int p = c >> 6; u.part = 1 + p; u.pm = 64 + ((c & 63) >> 2); u.pn = c & 3;
                if (K == 1024) { u.nt = 4; u.k0 = 256 * p; } else { u.nt = (p < 2) ? 12 : 10; u.k0 = (p < 2) ? 768 * p : 1536 + 640 * (p - 2); }
                return true; }
        }
        if (L >= nwg) return false;
        int wgid = (int)L; { const int q = nwg / NXCD, r = nwg % NXCD, xcd = wgid % NXCD, off = wgid / NXCD; wgid = (xcd < r ? xcd * (q + 1) : r * (q + 1) + (xcd - r) * q) + off; }
        const int nig = WGM * nN, gid = wgid / nig, fm = gid * WGM, gsz = (nM - fm) < WGM ? (nM - fm) : WGM;
        u.pm = fm + ((wgid % nig) % gsz); u.pn = (wgid % nig) / gsz; return true;
    }
};
template <class Epi, bool ALIGN_EPI>
__device__ __forceinline__ void gemm_phase(LAS unsigned char* lds, const Gemm g, const StaticOrder& S, const Epi& E, const int wid_in) {
    int tid_ = wid_in * 64 + lane_now(); asm volatile("" : "+v"(tid_));
    const int tid = tid_, wid = __builtin_amdgcn_readfirstlane(tid >> 6), lane = tid & 63, wr = wid >> 2, wc = wid & 3, fr = lane & 15, fq = lane >> 4;
    unsigned voffA[2], voffB[2];
#pragma unroll
    for (int i = 0; i < 2; ++i) { int R, C; stage_rc(tid * 16 + i * 8192, R, C); const int Rb = (R & ~31) + perm32(R & 31);
        voffA[i] = (unsigned)(R * g.lda + C) * 2u; voffB[i] = (unsigned)(Rb * g.ldb + C) * 2u; }
    const size_t kstep = (size_t)(BK * 2);
    const size_t hA = (size_t)HALF * g.lda * 2, hB = (size_t)HALF * g.ldb * 2, tA = 2 * hA, tB = 2 * hB;
    const unsigned ldsw = (unsigned)wid * 1024u;
    const int aoff = lds_byte(wr * 64 + fr, fq * 8), boff = lds_byte(wc * 32 + fr, fq * 8);
#define PG8_SA(b, h) (((b) * 2 + (h)) * HTB)
#define PG8_SB(b, h) ((4 + (b) * 2 + (h)) * HTB)
#define PG8_STAGE(bufoff, gbase, voff) do { _Pragma("unroll") for (int _i = 0; _i < 2; ++_i) \
        __builtin_amdgcn_global_load_lds((const unsigned*)((const char*)(gbase) + (voff)[_i]), (LAS unsigned*)(lds + (bufoff) + ldsw + _i * 8192), 16, 0, 0); } while (0)
#define PG8_LDA(dst, b, h) do { _Pragma("unroll") for (int m = 0; m < 4; ++m) _Pragma("unroll") for (int k = 0; k < 2; ++k) dst[m][k] = *(const LAS bf16x8*)(lds + PG8_SA(b, h) + aoff + m * 2048 + k * 1024); } while (0)
#define PG8_LDB(dst, b, h) do { _Pragma("unroll") for (int n = 0; n < 2; ++n) _Pragma("unroll") for (int k = 0; k < 2; ++k) dst[n][k] = *(const LAS bf16x8*)(lds + PG8_SB(b, h) + boff + n * 2048 + k * 1024); } while (0)
#define PG8_MMA(ai, bj, At, Bt) do { __builtin_amdgcn_s_setprio(1); _Pragma("unroll") for (int m = 0; m < 4; ++m) _Pragma("unroll") for (int n = 0; n < 2; ++n) _Pragma("unroll") for (int k = 0; k < 2; ++k) \
        acc[ai][bj][m][n] = __builtin_amdgcn_mfma_f32_16x16x32_bf16(Bt[n][k], At[m][k], acc[ai][bj][m][n], 0, 0, 0); __builtin_amdgcn_s_setprio(0); } while (0)
#define PG8_WAIT_V(n) asm volatile("s_waitcnt vmcnt(" #n ")" ::: "memory")
#define PG8_WAIT_L(n) asm volatile("s_waitcnt lgkmcnt(" #n ")" ::: "memory")
#define PG8_BAR __builtin_amdgcn_s_barrier()
#define PG8_SCHED __builtin_amdgcn_sched_barrier(0)
    Unit cur, nxt; int ui = 0;
#ifdef DBG_NOGEMM
    return;
#endif
    if (!S.next(0, cur)) return;
    f32x4 acc[2][2][4][2];
#pragma unroll
    for (int a = 0; a < 2; ++a)
#pragma unroll
        for (int b = 0; b < 2; ++b)
#pragma unroll
            for (int m = 0; m < 4; ++m)
#pragma unroll
                for (int n = 0; n < 2; ++n) acc[a][b][m][n] = (f32x4){0.f, 0.f, 0.f, 0.f};
    bf16x8 At[4][2], B0[2][2], B1[2][2];
    const char* cA = (const char*)g.A + (size_t)cur.pm * tA + (size_t)cur.k0 * 2; const char* cB = (const char*)g.Bt + (size_t)cur.pn * tB + (size_t)cur.k0 * 2;
    PG8_STAGE(PG8_SB(0, 0), cB, voffB); PG8_STAGE(PG8_SB(0, 1), cB + hB, voffB); PG8_STAGE(PG8_SA(0, 0), cA, voffA); PG8_STAGE(PG8_SA(0, 1), cA + hA, voffA);
    if (wr == 1) PG8_BAR;
    PG8_WAIT_V(2); PG8_BAR;
    PG8_STAGE(PG8_SB(1, 0), cB + kstep, voffB); PG8_STAGE(PG8_SA(1, 0), cA + kstep, voffA); PG8_STAGE(PG8_SB(1, 1), cB + hB + kstep, voffB);
    PG8_WAIT_V(6); PG8_BAR;
    for (;;) {
        const bool has_next = S.next(ui + 1, nxt);
        const char* nA = has_next ? (const char*)g.A + (size_t)nxt.pm * tA + (size_t)nxt.k0 * 2 : cA; const char* nB = has_next ? (const char*)g.Bt + (size_t)nxt.pn * tB + (size_t)nxt.k0 * 2 : cB;
        const int nt = cur.nt;
#pragma unroll 1
        for (int t = 0; t < nt; t += 2) {
            const bool last = (t == nt - 2);
            const char* a1 = cA + (size_t)(t + 1) * kstep;
            const char* a2 = last ? nA : cA + (size_t)(t + 2) * kstep; const char* b2 = last ? nB : cB + (size_t)(t + 2) * kstep;
            const char* a3 = a2 + kstep; const char* b3 = b2 + kstep;
            PG8_LDB(B0, 0, 0); PG8_LDB(B1, 0, 1); PG8_SCHED; PG8_LDA(At, 0, 0); PG8_STAGE(PG8_SA(1, 1), a1 + hA, voffA);
            PG8_WAIT_V(8); PG8_WAIT_L(0); PG8_BAR; PG8_MMA(0, 0, At, B0); PG8_MMA(0, 1, At, B1); PG8_BAR; PG8_SCHED;
            PG8_LDA(At, 0, 1); PG8_STAGE(PG8_SB(0, 0), b2, voffB); PG8_STAGE(PG8_SB(0, 1), b2 + hB, voffB); PG8_STAGE(PG8_SA(0, 0), a2, voffA);
            PG8_WAIT_V(8); PG8_WAIT_L(0); PG8_BAR; PG8_MMA(1, 0, At, B0); PG8_MMA(1, 1, At, B1); PG8_BAR; PG8_SCHED;
            PG8_LDB(B0, 1, 0); PG8_LDB(B1, 1, 1); PG8_SCHED; PG8_LDA(At, 1, 0); PG8_STAGE(PG8_SA(0, 1), a2 + hA, voffA);
            PG8_WAIT_V(8); PG8_WAIT_L(0); PG8_BAR; PG8_MMA(0, 0, At, B0); PG8_MMA(0, 1, At, B1); PG8_BAR; PG8_SCHED;
            PG8_LDA(At, 1, 1); PG8_STAGE(PG8_SB(1, 0), b3, voffB); PG8_STAGE(PG8_SB(1, 1), b3 + hB, voffB); PG8_STAGE(PG8_SA(1, 0), a3, voffA);
            PG8_WAIT_V(8); PG8_WAIT_L(0); PG8_BAR; PG8_MMA(1, 0, At, B0); PG8_MMA(1, 1, At, B1); PG8_BAR; PG8_SCHED;
        }
        if constexpr (ALIGN_EPI) { if (wr == 0) PG8_BAR; }
        E(acc, cur, wr, wc, fr, fq);
        if (!has_next) break;
#pragma unroll
        for (int a = 0; a < 2; ++a)
#pragma unroll
            for (int b = 0; b < 2; ++b)
#pragma unroll
                for (int m = 0; m < 4; ++m)
#pragma unroll
                    for (int n = 0; n < 2; ++n) acc[a][b][m][n] = (f32x4){0.f, 0.f, 0.f, 0.f};
        cur = nxt; cA = nA; cB = nB; ++ui;
        if constexpr (ALIGN_EPI) { if (wr == 1) PG8_BAR; }
    }
    PG8_WAIT_V(0);
    if constexpr (!ALIGN_EPI) { if (wr == 0) PG8_BAR; }
    PG8_BAR;
#undef PG8_SA
#undef PG8_SB
#undef PG8_STAGE
#undef PG8_LDA
#undef PG8_LDB
#undef PG8_MMA
#undef PG8_WAIT_V
#undef PG8_WAIT_L
#undef PG8_BAR
#undef PG8_SCHED
}

typedef f32x4 AccT[2][2][4][2];
__device__ __forceinline__ u32x4 pack8(const f32x4 v0, const f32x4 v1) { u32x4 w; w.x = cvtpk(v0[0], v0[1]); w.y = cvtpk(v0[2], v0[3]); w.z = cvtpk(v1[0], v1[1]); w.w = cvtpk(v1[2], v1[3]); return w; }

struct EpiStore {
    bf16_t* O; int ldc;
    __device__ __forceinline__ void operator()(const AccT& acc, const Unit& u, int wr, int wc, int fr, int fq) const {
        const int row0 = u.pm * BM + wr * 64 + fr, col0 = u.pn * BM + wc * 32 + 8 * fq;
#pragma unroll
        for (int ai = 0; ai < 2; ++ai)
#pragma unroll
            for (int m = 0; m < 4; ++m) { bf16_t* rowp = O + (size_t)(row0 + ai * HALF + m * 16) * ldc + col0;
#pragma unroll
                for (int bj = 0; bj < 2; ++bj) *(u32x4*)(rowp + bj * HALF) = pack8(acc[ai][bj][m][0], acc[ai][bj][m][1]); }
    }
};
struct EpiInA {
    bf16_t* P; float* st_nk; float* st_nv; float* st_kr; float* st_ckv; const float* qn; const float* kvn; const float* cosM; const float* sinM; bf16_t* KR; LAS float* xch;
    __device__ __forceinline__ void operator()(const AccT& acc, const Unit& u, int wr, int wc, int fr, int fq) const {
        const int row0 = u.pm * BM + wr * 64 + fr, pn = u.pn, col0 = pn * BM + wc * 32 + 8 * fq;
        const bool ctx = u.pm < 16;
        if (pn <= 1) {
            int lane = fr + 16 * fq; asm volatile("" : "+v"(lane));
            float ss[2][4];
#pragma unroll
            for (int ai = 0; ai < 2; ++ai)
#pragma unroll
                for (int m = 0; m < 4; ++m) {
                    float sq = 0.f;
#pragma unroll
                    for (int bj = 0; bj < 2; ++bj)
#pragma unroll
                        for (int n = 0; n < 2; ++n) { const f32x4 v = acc[ai][bj][m][n]; sq += v[0] * v[0] + v[1] * v[1] + v[2] * v[2] + v[3] * v[3]; }
                    sq += __builtin_bit_cast(float, __builtin_amdgcn_ds_bpermute((lane ^ 16) << 2, __builtin_bit_cast(int, sq)));
                    sq += __builtin_bit_cast(float, __builtin_amdgcn_ds_bpermute((lane ^ 32) << 2, __builtin_bit_cast(int, sq)));
                    ss[ai][m] = sq;
                }
            if (fq == 0) {
#pragma unroll
                for (int ai = 0; ai < 2; ++ai)
#pragma unroll
                    for (int m = 0; m < 4; ++m) xch[(ai * HALF + wr * 64 + m * 16 + fr) * 4 + wc] = ss[ai][m];
            }
            asm volatile("s_waitcnt lgkmcnt(0)" ::: "memory"); __builtin_amdgcn_s_barrier(); asm volatile("" ::: "memory");
            const float* g = (pn == 0 ? qn : kvn) + wc * 32 + 8 * fq;
            f32x4 gv[2][2];
#pragma unroll
            for (int bj = 0; bj < 2; ++bj) { gv[bj][0] = *(const f32x4*)(g + bj * HALF); gv[bj][1] = *(const f32x4*)(g + bj * HALF + 4); }
#pragma unroll
            for (int ai = 0; ai < 2; ++ai)
#pragma unroll
                for (int m = 0; m < 4; ++m) {
                    const f32x4 t4 = *(const LAS f32x4*)(xch + (ai * HALF + wr * 64 + m * 16 + fr) * 4);
                    const float rstd = 1.0f / sqrtf(((t4[0] + t4[1]) + (t4[2] + t4[3])) * (1.0f / 256.0f) + RMS_EPS);
                    const int row = row0 + ai * HALF + m * 16;
#pragma unroll
                    for (int bj = 0; bj < 2; ++bj) {
                        const int col = col0 + bj * HALF;
                        const f32x4 v0 = acc[ai][bj][m][0] * rstd * gv[bj][0], v1 = acc[ai][bj][m][1] * rstd * gv[bj][1];
                        *(u32x4*)(P + (size_t)row * LDP + col) = pack8(v0, v1);
                        if (pn == 1 && ctx) { float* d = st_ckv + (size_t)row * 256 + (col - 256); *(f32x4*)d = v0; *(f32x4*)(d + 4) = v1; }
                    }
                }
            return;
        }
        if (pn == 8) {
            if (wc != 0) return;
            int lane = fr + 16 * fq; asm volatile("" : "+v"(lane));
#pragma unroll
            for (int ai = 0; ai < 2; ++ai)
#pragma unroll
                for (int m = 0; m < 4; ++m) {
                    const int row = row0 + ai * HALF + m * 16;
                    const f32x4 v0 = acc[ai][0][m][0], v1 = acc[ai][0][m][1];
                    if (ctx) { float* d = st_kr + (size_t)row * 32 + 8 * fq; *(f32x4*)d = v0; *(f32x4*)(d + 4) = v1; }
                    f32x4 y[2] = {v0, v1};
                    const int t = (row - MCTX) & 4095;
#pragma unroll
                    for (int n = 0; n < 2; ++n) {
                        const f32x4 own = n == 0 ? v0 : v1; f32x4 oth;
#pragma unroll
                        for (int e = 0; e < 4; ++e) oth[e] = __builtin_bit_cast(float, __builtin_amdgcn_ds_bpermute((lane ^ 32) << 2, __builtin_bit_cast(int, own[e])));
                        if (!ctx) {
                            const f32x4 c = *(const f32x4*)(cosM + (size_t)t * 16 + 8 * (fq & 1) + 4 * n), sn = *(const f32x4*)(sinM + (size_t)t * 16 + 8 * (fq & 1) + 4 * n);
                            y[n] = (fq < 2) ? (own * c - oth * sn) : (oth * sn + own * c);
                        }
                    }
                    u32x2 w0, w1; w0.x = cvtpk(y[0][0], y[0][1]); w0.y = cvtpk(y[0][2], y[0][3]); w1.x = cvtpk(y[1][0], y[1][1]); w1.y = cvtpk(y[1][2], y[1][3]);
                    *(u32x2*)(KR + (size_t)row * 32 + 8 * fq) = w0; *(u32x2*)(KR + (size_t)row * 32 + 8 * fq + 4) = w1;
                }
            return;
        }
#pragma unroll
        for (int ai = 0; ai < 2; ++ai)
#pragma unroll
            for (int m = 0; m < 4; ++m) { const int row = row0 + ai * HALF + m * 16;
#pragma unroll
                for (int bj = 0; bj < 2; ++bj) {
                    const int col = col0 + bj * HALF; const f32x4 v0 = acc[ai][bj][m][0], v1 = acc[ai][bj][m][1];
                    *(u32x4*)(P + (size_t)row * LDP + col) = pack8(v0, v1);
                    if (ctx) {
                        float* d = nullptr;
                        if (pn == 4 || pn == 5) d = st_nk + (size_t)row * 512 + (col - 1024);
                        else if (pn == 6 || pn == 7) d = st_nv + (size_t)row * 512 + (col - 1536);
                        if (d) { *(f32x4*)d = v0; *(f32x4*)(d + 4) = v1; }
                    }
                } }
    }
};
struct EpiInC {
    bf16_t* P; float* st_gv;
    __device__ __forceinline__ void operator()(const AccT& acc, const Unit& u, int wr, int wc, int fr, int fq) const {
        const int row0 = u.pm * BM + wr * 64 + fr, pn = u.pn, col0 = pn * BM + wc * 32 + 8 * fq;
        const bool st = (u.pm < 16) && (pn == 5);
#pragma unroll
        for (int ai = 0; ai < 2; ++ai)
#pragma unroll
            for (int m = 0; m < 4; ++m) { const int row = row0 + ai * HALF + m * 16;
#pragma unroll
                for (int bj = 0; bj < 2; ++bj) {
                    const int col = col0 + bj * HALF; const f32x4 v0 = acc[ai][bj][m][0], v1 = acc[ai][bj][m][1];
                    *(u32x4*)(P + (size_t)row * NINC + col) = pack8(v0, v1);
                    if (st) { float* d = st_gv + (size_t)row * 256 + (col - 1280); *(f32x4*)d = v0; *(f32x4*)(d + 4) = v1; }
                } }
    }
};
struct EpiRes {
    const float* srcLo; const float* srcHi; float* dst; const float* gate; bf16_t* part;
    __device__ __forceinline__ void operator()(const AccT& acc, const Unit& u, int wr, int wc, int fr, int fq) const {
        const int row0 = u.pm * BM + wr * 64 + fr, col0 = u.pn * BM + wc * 32 + 8 * fq;
        const int grp = u.pm < 16 ? 4 : ((u.pm - 16) >> 4);
        const float* gp = gate + grp * 6144 + col0;
        f32x4 gv[2][2];
#pragma unroll
        for (int bj = 0; bj < 2; ++bj) { gv[bj][0] = *(const f32x4*)(gp + bj * HALF); gv[bj][1] = *(const f32x4*)(gp + bj * HALF + 4); }
        const float* src = (u.pm < 16) ? srcLo : (srcHi - (size_t)MCTX * D);
#pragma unroll
        for (int ai = 0; ai < 2; ++ai)
#pragma unroll
            for (int m = 0; m < 4; ++m) { const size_t off = (size_t)(row0 + ai * HALF + m * 16) * D + col0;
#pragma unroll
                for (int bj = 0; bj < 2; ++bj) {
                    if (u.part) {
                        bf16_t* d = part + (size_t)(u.part - 1) * 4096 * 1024 + (off - (size_t)16384 * D) + bj * HALF;
                        *(u32x4*)d = pack8(gv[bj][0] * acc[ai][bj][m][0], gv[bj][1] * acc[ai][bj][m][1]);
                    } else {
                    const f32x4 x0 = *(const f32x4*)(src + off + bj * HALF), x1 = *(const f32x4*)(src + off + bj * HALF + 4);
                    *(f32x4*)(dst + off + bj * HALF) = x0 + gv[bj][0] * acc[ai][bj][m][0];
                    *(f32x4*)(dst + off + bj * HALF + 4) = x1 + gv[bj][1] * acc[ai][bj][m][1];
                    }
                } }
    }
};
struct EpiSwiglu {
    bf16_t* HF;
    __device__ __forceinline__ void operator()(const AccT& acc, const Unit& u, int wr, int wc, int fr, int fq) const {
        const int row0 = u.pm * BM + wr * 64 + fr, col0 = u.pn * HALF + wc * 32 + 8 * fq;
#pragma unroll
        for (int ai = 0; ai < 2; ++ai)
#pragma unroll
            for (int m = 0; m < 4; ++m) {
                f32x4 h[2];
#pragma unroll
                for (int n = 0; n < 2; ++n) { const f32x4 gt = acc[ai][0][m][n], up = acc[ai][1][m][n];
#pragma unroll
                    for (int e = 0; e < 4; ++e) { const float s = __builtin_amdgcn_rcpf(1.0f + __builtin_amdgcn_exp2f(-gt[e] * LOG2E)); h[n][e] = gt[e] * s * up[e]; } }
                *(u32x4*)(HF + (size_t)(row0 + ai * HALF + m * 16) * DFF + col0) = pack8(h[0], h[1]);
            }
    }
};
}

struct AttnArgs {
    const bf16_t* Q; int ldq;
    const bf16_t* Ka; int ldka; const bf16_t* Kb; int ldkb; const bf16_t* V; int ldv;
    bf16_t* O; int ldo;
    int qrow0;
    int seg0row, seg0n, seg1row, seg1n;
    float scale_log2;
    int rope; int tpos0;
    const float* cosT; const float* sinT; const float* qnorm;
    const float* rpb; int r0, rsmin;
};
__device__ __forceinline__ void glds16(const void* gsrc, unsigned lds_dst) { unsigned keep;
    asm volatile("s_mov_b32 %0, m0\n\ts_mov_b32 m0, %2\n\ts_nop 0\n\tglobal_load_lds_dwordx4 %1, off\n\ts_mov_b32 m0, %0" : "=&s"(keep) : "v"(gsrc), "s"(lds_dst) : "memory"); }
__device__ __forceinline__ float max3f(float a, float b, float c) { float r; asm("v_max3_f32 %0, %1, %2, %3" : "=v"(r) : "v"(a), "v"(b), "v"(c)); return r; }
__device__ __forceinline__ float max2f(float a, float b) { float r; asm("v_max_f32_e32 %0, %1, %2" : "=v"(r) : "v"(a), "v"(b)); return r; }
__device__ __forceinline__ int crow(int r, int hi) { return (r & 3) + 8 * (r >> 2) + 4 * hi; }

template <int DQK, int DV, int KSPLIT, int QMODE  , bool NA>
__device__ __forceinline__ void attn_unit(LAS unsigned char* lds, const AttnArgs& a, const int wid_in) {
    constexpr int KROW = (DQK > 64) ? 256 : 128, VROW = DV * 2;
    constexpr int KBUF = 64 * KROW, VBUF = 64 * VROW;
    constexpr int NKD = KBUF / 8192, NVD = VBUF / 8192;
    constexpr int ND0 = DQK / 16, NDB = DV / 32;
    constexpr int OFF_K = 0, OFF_V = 4 * KBUF, OFF_RPB = 4 * KBUF + 3 * VBUF;
    int tid_ = wid_in * 64 + lane_now(); asm volatile("" : "+v"(tid_));
    const int tid = tid_, lane = tid & 63, r32 = lane & 31, hi = lane >> 5;
    const int wid = __builtin_amdgcn_readfirstlane(tid >> 6);
    const int n0t = a.seg0n >> 6, NT = n0t + (a.seg1n >> 6);

    const bf16_t* kp[NKD]; int kst[NKD]; const bf16_t* vp[NVD];
#pragma unroll
    for (int i = 0; i < NKD; ++i) {
        int row, c;
        if (KROW == 256) { row = 8 * wid + 4 * i + (lane >> 4); c = (lane & 15) ^ (row & 15); }
        else { row = 8 * wid + (lane >> 3); c = (lane & 7) ^ ((row >> 1) & 7); }
        if (c >= DQK / 8) c = 0;
        if (c < KSPLIT) { kp[i] = a.Ka + (size_t)row * a.ldka + c * 8; kst[i] = a.ldka; }
        else { kp[i] = a.Kb + (size_t)row * a.ldkb + (c - KSPLIT) * 8; kst[i] = a.ldkb; }
    }
#pragma unroll
    for (int i = 0; i < NVD; ++i) {
        int row, c;
        if (VROW == 256) { row = 8 * wid + 4 * i + (lane >> 4); c = (lane & 15) ^ (4 * (row & 3)); }
        else { row = 8 * wid + (lane >> 3); c = (lane & 7) ^ (4 * ((row >> 1) & 1)); }
        vp[i] = a.V + (size_t)row * a.ldv + c * 8;
    }
    const unsigned lds0 = (unsigned)(uintptr_t)lds;
    auto tile_rb = [&](int t) { t = t < NT ? t : NT - 1; return (t < n0t) ? (a.seg0row + 64 * t) : (a.seg1row + 64 * (t - n0t)); };
    auto issueK = [&](int t, int slot) {
        const int rb = tile_rb(t);
#pragma unroll
        for (int i = 0; i < NKD; ++i)
            glds16(kp[i] + (size_t)rb * kst[i], (unsigned)__builtin_amdgcn_readfirstlane((int)(lds0 + OFF_K + slot * KBUF + (wid * NKD + i) * 1024)));
    };
    auto issueV = [&](int t, int slot) {
        const int rb = tile_rb(t);
#pragma unroll
        for (int i = 0; i < NVD; ++i)
            glds16(vp[i] + (size_t)rb * a.ldv, (unsigned)__builtin_amdgcn_readfirstlane((int)(lds0 + OFF_V + slot * VBUF + (wid * NVD + i) * 1024)));
    };

    issueK(0, 0); issueV(0, 0); issueK(1, 1); issueV(1, 1); issueK(2, 2);
    if (NA) { for (int i = tid; i < 465; i += 512) *(LAS float*)(lds + OFF_RPB + i * 4) = a.rpb[i] * LOG2E; }

    const int qrow = a.qrow0 + wid * 32 + r32;
    bf16x8 qf[ND0];
    {
        const bf16_t* qp = a.Q + (size_t)qrow * a.ldq + hi * 8;
        u32x4 qraw[ND0];
#pragma unroll
        for (int d0 = 0; d0 < ND0; ++d0) qraw[d0] = *(const u32x4*)(qp + d0 * 16);
        if (QMODE == 1) {
            if (a.rope) {
                const int tpos = a.tpos0 + wid * 32 + r32;
                const float* cp = a.cosT + (size_t)tpos * 16 + hi * 8; const float* sp = a.sinT + (size_t)tpos * 16 + hi * 8;
                const f32x4 c0 = *(const f32x4*)cp, c1 = *(const f32x4*)(cp + 4), s0 = *(const f32x4*)sp, s1 = *(const f32x4*)(sp + 4);
                float cc[8] = {c0[0], c0[1], c0[2], c0[3], c1[0], c1[1], c1[2], c1[3]}, ss[8] = {s0[0], s0[1], s0[2], s0[3], s1[0], s1[1], s1[2], s1[3]};
                u32x4 y1, y2;
#pragma unroll
                for (int w = 0; w < 4; ++w) {
                    const float a0 = bf_lo(qraw[4][w]), a1 = bf_hi(qraw[4][w]), b0 = bf_lo(qraw[5][w]), b1 = bf_hi(qraw[5][w]);
                    y1[w] = cvtpk(a0 * cc[2 * w] - b0 * ss[2 * w], a1 * cc[2 * w + 1] - b1 * ss[2 * w + 1]);
                    y2[w] = cvtpk(a0 * ss[2 * w] + b0 * cc[2 * w], a1 * ss[2 * w + 1] + b1 * cc[2 * w + 1]);
                }
                qraw[4] = y1; qraw[5] = y2;
            }
        }
        if (QMODE == 2) {
            float ssq = 0.f;
#pragma unroll
            for (int d0 = 0; d0 < ND0; ++d0)
#pragma unroll
                for (int w = 0; w < 4; ++w) { const float x0 = bf_lo(qraw[d0][w]), x1 = bf_hi(qraw[d0][w]); ssq += x0 * x0 + x1 * x1; }
            ssq = half_sum(ssq);
            const float rstd = a.scale_log2 / sqrtf(ssq * (1.0f / 128.0f) + RMS_EPS);
            const int tpos = a.tpos0 + wid * 32 + r32;
#pragma unroll
            for (int d0 = 0; d0 < 4; ++d0) {
                const float* g1 = a.qnorm + 16 * d0 + 8 * hi; const float* g2 = g1 + 64;
                const float* cp = a.cosT + (size_t)tpos * 64 + 16 * d0 + 8 * hi; const float* sp = a.sinT + (size_t)tpos * 64 + 16 * d0 + 8 * hi;
                f32x4 cv[2] = {(f32x4){1.f, 1.f, 1.f, 1.f}, (f32x4){1.f, 1.f, 1.f, 1.f}}, sv[2] = {(f32x4){0.f, 0.f, 0.f, 0.f}, (f32x4){0.f, 0.f, 0.f, 0.f}};
                if (a.rope) { cv[0] = *(const f32x4*)cp; cv[1] = *(const f32x4*)(cp + 4); sv[0] = *(const f32x4*)sp; sv[1] = *(const f32x4*)(sp + 4); }
                u32x4 y1, y2;
#pragma unroll
                for (int w = 0; w < 4; ++w) {
                    float a0 = bf_lo(qraw[d0][w]) * rstd * g1[2 * w], a1 = bf_hi(qraw[d0][w]) * rstd * g1[2 * w + 1];
                    float b0 = bf_lo(qraw[d0 + 4][w]) * rstd * g2[2 * w], b1 = bf_hi(qraw[d0 + 4][w]) * rstd * g2[2 * w + 1];
                    if (a.rope) {
                        const float c0 = cv[w >> 1][(2 * w) & 3], c1 = cv[w >> 1][(2 * w + 1) & 3], s0 = sv[w >> 1][(2 * w) & 3], s1 = sv[w >> 1][(2 * w + 1) & 3];
                        const float n0 = a0 * c0 - b0 * s0, n1 = a1 * c1 - b1 * s1, m0 = a0 * s0 + b0 * c0, m1 = a1 * s1 + b1 * c1;
                        a0 = n0; a1 = n1; b0 = m0; b1 = m1;
                    }
                    y1[w] = cvtpk(a0, a1); y2[w] = cvtpk(b0, b1);
                }
                qraw[d0] = y1; qraw[d0 + 4] = y2;
            }
        }
        if (QMODE != 2) {
#pragma unroll
            for (int d0 = 0; d0 < ND0; ++d0)
#pragma unroll
                for (int w = 0; w < 4; ++w) qraw[d0][w] = cvtpk(bf_lo(qraw[d0][w]) * a.scale_log2, bf_hi(qraw[d0][w]) * a.scale_log2);
        }
#pragma unroll
        for (int d0 = 0; d0 < ND0; ++d0) qf[d0] = __builtin_bit_cast(bf16x8, qraw[d0]);
    }

    f32x16 o[NDB];
#pragma unroll
    for (int i = 0; i < NDB; ++i) o[i] = f32x16{};
    constexpr bool NEGC = (DV == 64);
    float m_run = NEGC ? 0.f : -1e30f, l_run = 0.f;
    f32x16 negm16 = f32x16{};

    const int qr = NA ? (a.r0 + (wid >> 1)) : 0;
    const int qc = NA ? ((wid & 1) * 32 + r32) : 0;
    const int rs = NA ? min(max(qr - 4, 0), 56) : 0;
    const int cs = NA ? min(max(qc - 8, 0), 48) : 0;

    const int ksw = (KROW == 256) ? (r32 & 15) : ((r32 >> 1) & 7);
    const int ke = hi ^ ksw;
    const LAS unsigned char* krow = lds + OFF_K + r32 * KROW;
    auto qk = [&](int slot, f32x16& p0, f32x16& p1, const f32x16& cinit) {
        const LAS unsigned char* kb = krow + slot * KBUF;
#pragma unroll
        for (int d0 = 0; d0 < ND0; ++d0) {
            const int co = ((2 * d0) ^ ke) * 16;
            const bf16x8 k0 = *(const LAS bf16x8*)(kb + co);
            const bf16x8 k1 = *(const LAS bf16x8*)(kb + 32 * KROW + co);
            p0 = __builtin_amdgcn_mfma_f32_32x32x16_bf16(k0, qf[d0], d0 == 0 ? cinit : p0, 0, 0, 0);
            p1 = __builtin_amdgcn_mfma_f32_32x32x16_bf16(k1, qf[d0], d0 == 0 ? cinit : p1, 0, 0, 0);
        }
    };
    const int q4 = (lane & 15) >> 2, pp = lane & 3, blk = (lane >> 4) & 1;
    const int vsw = (VROW == 256) ? q4 : ((q4 >> 1) & 1);
    const int vlane_off = (4 * hi + q4) * VROW + 32 * blk + 8 * pp;
    constexpr float THR = 8.0f;
#define ATT_WAIT_BAR(N) do { asm volatile("s_waitcnt vmcnt(%0) lgkmcnt(0)" :: "n"(N) : "memory"); __builtin_amdgcn_s_barrier(); asm volatile("" ::: "memory"); } while (0)

    ATT_WAIT_BAR(2 * NKD + 2 * NVD);
    f32x16 p0, p1, n0, n1;
    qk(0, p0, p1, negm16);
    auto na_skip = [&](int t) { if (!NA || t < n0t || t >= NT) return false; const int kr = a.rsmin + (t - n0t); return (kr < rs) || (kr >= rs + 8); };
    int ks1 = 1, ks3 = 3, vs0 = 0, vs2 = 2;
    auto step = [&](int t, f32x16& p0, f32x16& p1, f32x16& n0, f32x16& n1) {
        ATT_WAIT_BAR(NKD + NVD);
        issueK(t + 3, ks3); issueV(t + 2, vs2);
        constexpr int HA = ND0 / 2;
        bf16x8 kA0[HA], kA1[HA];
        const LAS unsigned char* kbn = krow + ks1 * KBUF;
        if (!NA) {
#pragma unroll
            for (int d0 = 0; d0 < HA; ++d0) { const int co = ((2 * d0) ^ ke) * 16; kA0[d0] = *(const LAS bf16x8*)(kbn + co); kA1[d0] = *(const LAS bf16x8*)(kbn + 32 * KROW + co); }
            __builtin_amdgcn_sched_barrier(0);
        }
        const bool skip = na_skip(t);
        if (!skip) {
            if (NA && t >= n0t) {
                const int kr = a.rsmin + (t - n0t);
                const LAS float* bt = (const LAS float*)(lds + OFF_RPB) + (kr - qr + 7) * 31;
#pragma unroll
                for (int r = 0; r < 16; ++r) {
                    const int kc0 = crow(r, hi), kc1 = kc0 + 32;
                    const bool v0 = (kc0 >= cs) && (kc0 < cs + 16), v1 = (kc1 >= cs) && (kc1 < cs + 16);
                    const int i0 = min(max(kc0 - qc + 15, 0), 30), i1 = min(max(kc1 - qc + 15, 0), 30);
                    const float b0 = bt[i0], b1 = bt[i1];
                    p0[r] = v0 ? (p0[r] + b0) : -1e30f;
                    p1[r] = v1 ? (p1[r] + b1) : -1e30f;
                }
            }
            float mx = max2f(p0[0], p1[0]), mx2 = max2f(p0[1], p1[1]);
#pragma unroll
            for (int r = 2; r < 16; r += 2) { mx = max3f(mx, p0[r], p1[r]); mx2 = max3f(mx2, p0[r + 1], p1[r + 1]); }
            mx = max2f(mx, mx2);
            mx = half_max(mx);
            float negm = 0.f;
            if (NEGC) {
                if (t == 0 || __any(mx > THR)) {
                    const float dl = (t == 0) ? mx : fmaxf(mx, 0.f);
                    m_run += dl;
#pragma unroll
                    for (int r = 0; r < 16; ++r) { p0[r] -= dl; p1[r] -= dl; }
                    if (t != 0) {
                        const float f = __builtin_amdgcn_exp2f(-dl);
                        l_run *= f;
#pragma unroll
                        for (int i = 0; i < NDB; ++i)
#pragma unroll
                            for (int r = 0; r < 16; ++r) o[i][r] *= f;
                    }
#pragma unroll
                    for (int r = 0; r < 16; ++r) negm16[r] = -m_run;
                }
            } else {
                if (__any(mx > m_run + THR)) {
                    const float m_new = max2f(m_run, mx);
                    const float alpha = __builtin_amdgcn_exp2f(m_run - m_new);
                    m_run = m_new; l_run *= alpha;
#pragma unroll
                    for (int i = 0; i < NDB; ++i)
#pragma unroll
                        for (int r = 0; r < 16; ++r) o[i][r] *= alpha;
                }
                negm = -m_run;
            }
            if (!NA) {
#pragma unroll
                for (int d0 = 0; d0 < HA; ++d0) {
                    n0 = __builtin_amdgcn_mfma_f32_32x32x16_bf16(kA0[d0], qf[d0], d0 == 0 ? negm16 : n0, 0, 0, 0);
                    n1 = __builtin_amdgcn_mfma_f32_32x32x16_bf16(kA1[d0], qf[d0], d0 == 0 ? negm16 : n1, 0, 0, 0);
                }
                bf16x8 kB0[ND0 - HA], kB1[ND0 - HA];
#pragma unroll
                for (int d0 = HA; d0 < ND0; ++d0) { const int co = ((2 * d0) ^ ke) * 16; kB0[d0 - HA] = *(const LAS bf16x8*)(kbn + co); kB1[d0 - HA] = *(const LAS bf16x8*)(kbn + 32 * KROW + co); }
#pragma unroll
                for (int d0 = HA; d0 < ND0; ++d0) {
                    n0 = __builtin_amdgcn_mfma_f32_32x32x16_bf16(kB0[d0 - HA], qf[d0], n0, 0, 0, 0);
                    n1 = __builtin_amdgcn_mfma_f32_32x32x16_bf16(kB1[d0 - HA], qf[d0], n1, 0, 0, 0);
                }
            } else {
                if (!na_skip(t + 1)) qk(ks1, n0, n1, negm16);
            }
            {
                f32x2_t sum2 = {0.f, 0.f};
#pragma unroll
                for (int r = 0; r < 16; r += 2) {
                    f32x2_t a2 = {p0[r], p0[r + 1]}, b2 = {p1[r], p1[r + 1]};
                    if (!NEGC) { const f32x2_t nm2 = {negm, negm}; a2 += nm2; b2 += nm2; }
                    a2.x = __builtin_amdgcn_exp2f(a2.x); a2.y = __builtin_amdgcn_exp2f(a2.y); b2.x = __builtin_amdgcn_exp2f(b2.x); b2.y = __builtin_amdgcn_exp2f(b2.y);
                    sum2 += a2; sum2 += b2;
                    p0[r] = a2.x; p0[r + 1] = a2.y; p1[r] = b2.x; p1[r + 1] = b2.y;
                }
                l_run += sum2.x + sum2.y;
            }
            bf16x8 pa[4];
            {
                u32x4 w;
                w.x = cvtpk(p0[0], p0[1]); w.y = cvtpk(p0[2], p0[3]); w.z = cvtpk(p0[4], p0[5]); w.w = cvtpk(p0[6], p0[7]); pa[0] = __builtin_bit_cast(bf16x8, w);
                w.x = cvtpk(p0[8], p0[9]); w.y = cvtpk(p0[10], p0[11]); w.z = cvtpk(p0[12], p0[13]); w.w = cvtpk(p0[14], p0[15]); pa[1] = __builtin_bit_cast(bf16x8, w);
                w.x = cvtpk(p1[0], p1[1]); w.y = cvtpk(p1[2], p1[3]); w.z = cvtpk(p1[4], p1[5]); w.w = cvtpk(p1[6], p1[7]); pa[2] = __builtin_bit_cast(bf16x8, w);
                w.x = cvtpk(p1[8], p1[9]); w.y = cvtpk(p1[10], p1[11]); w.z = cvtpk(p1[12], p1[13]); w.w = cvtpk(p1[14], p1[15]); pa[3] = __builtin_bit_cast(bf16x8, w);
            }
            const LAS unsigned char* vb = lds + OFF_V + vs0 * VBUF + vlane_off;
#pragma unroll
            for (int ks = 0; ks < 4; ++ks)
#pragma unroll
                for (int db = 0; db < NDB; ++db) {
                    const LAS unsigned char* vq = vb + (16 * ks) * VROW + ((db ^ vsw) * 64);
                    const s16x4 lo = __builtin_bit_cast(s16x4, __builtin_amdgcn_ds_read_tr16_b64_v4i16((LAS s16x4*)(vq)));
                    const s16x4 hh = __builtin_bit_cast(s16x4, __builtin_amdgcn_ds_read_tr16_b64_v4i16((LAS s16x4*)(vq + 8 * VROW)));
                    const bf16x8 vf = (bf16x8){lo[0], lo[1], lo[2], lo[3], hh[0], hh[1], hh[2], hh[3]};
                    o[db] = __builtin_amdgcn_mfma_f32_32x32x16_bf16(vf, pa[ks], o[db], 0, 0, 0);
                }
        } else { if (NA && !na_skip(t + 1)) qk(ks1, n0, n1, negm16); }
        ks1 = (ks1 + 1) & 3; ks3 = (ks3 + 1) & 3; vs0 = (vs0 == 2) ? 0 : vs0 + 1; vs2 = (vs2 == 2) ? 0 : vs2 + 1;
    };
    {
        int t = 0;
        for (; t + 1 < NT; t += 2) { step(t, p0, p1, n0, n1); step(t + 1, n0, n1, p0, p1); }
        if (t < NT) step(t, p0, p1, n0, n1);
    }
    const float lt = half_sum(l_run);
    const float inv = 1.0f / lt;
    ATT_WAIT_BAR(0);
    {
        constexpr int OP = DV * 2 + 8;
        int lane2 = lane; asm volatile("" : "+v"(lane2));
        const int e32 = lane2 & 31, ehi = lane2 >> 5;
        LAS unsigned char* stg = lds + wid * (32 * OP);
#pragma unroll
        for (int db = 0; db < NDB; ++db)
#pragma unroll
            for (int r4 = 0; r4 < 4; ++r4) {
                u32x2 w; w.x = cvtpk(o[db][4 * r4] * inv, o[db][4 * r4 + 1] * inv); w.y = cvtpk(o[db][4 * r4 + 2] * inv, o[db][4 * r4 + 3] * inv);
                *(LAS u32x2*)(stg + e32 * OP + (32 * db + 8 * r4 + 4 * ehi) * 2) = w;
            }
        constexpr int CH = DV / 8, RPI = 64 / CH;
        bf16_t* ob = a.O + (size_t)(a.qrow0 + wid * 32) * a.ldo;
#pragma unroll
        for (int i = 0; i < 32 / RPI; ++i) {
            const int row = i * RPI + lane2 / CH, ch = lane2 % CH;
            const u32x2 lo = *(const LAS u32x2*)(stg + row * OP + ch * 16), hh = *(const LAS u32x2*)(stg + row * OP + ch * 16 + 8);
            *(u32x4*)(ob + (size_t)row * a.ldo + ch * 8) = (u32x4){lo.x, lo.y, hh.x, hh.y};
        }
    }
    ATT_WAIT_BAR(0);
#undef ATT_WAIT_BAR
}

struct KArgs { const float* in[28]; float* out; unsigned char* ws; };

__device__ __forceinline__ void transpose_item(const float* W, int K, int N, bf16_t* WT, int mapmode, LAS float* scr, int item, int lane) {
    const int nblk = N / 32, kb = item / nblk, nb = item % nblk, k0 = 64 * kb, n0 = 32 * nb;
    int d0 = n0;
    if (mapmode == 1) {
        if (n0 < 512) d0 = n0; else if (n0 < 544) d0 = 2048 + (n0 - 512); else d0 = n0 - 32;
    } else if (mapmode == 2) {
        if (n0 < DFF) d0 = (n0 >> 7) * 256 + (n0 & 127); else { const int j = n0 - DFF; d0 = (j >> 7) * 256 + 128 + (j & 127); }
    }
#pragma unroll 8
    for (int i = 0; i < 32; ++i) { const int kk = 2 * i + (lane >> 5); scr[kk * 33 + (lane & 31)] = W[(size_t)(k0 + kk) * N + n0 + (lane & 31)]; }
    asm volatile("s_waitcnt lgkmcnt(0)" ::: "memory");
    const int c = lane & 7;
#pragma unroll
    for (int j = 0; j < 4; ++j) { const int n = (lane >> 3) + 8 * j; const LAS float* s = scr + (8 * c) * 33 + n;
        u32x4 o; o.x = cvtpk(s[0 * 33], s[1 * 33]); o.y = cvtpk(s[2 * 33], s[3 * 33]); o.z = cvtpk(s[4 * 33], s[5 * 33]); o.w = cvtpk(s[6 * 33], s[7 * 33]);
        *(u32x4*)(WT + (size_t)(d0 + n) * K + k0 + 8 * c) = o; }
    asm volatile("s_waitcnt lgkmcnt(0)" ::: "memory");
}

__device__ __forceinline__ void tjob(const float* W, int K, int N, bf16_t* WT, int map, int& base, LAS unsigned char* lds, int gw, int NGW, int wid, int lane) {
    asm volatile("" : "+v"(lane));
    LAS float* scr = (LAS float*)(lds + wid * 16384);
    const int items = (K / 64) * (N / 32);
    const int first = ((gw - base) % NGW + NGW) % NGW;
    for (int it = first; it < items; it += NGW) transpose_item(W, K, N, WT, map, scr, it, lane);
    base += items;
}

__device__ __forceinline__ void norm_mod_rows(const float* srcLo, const float* srcHi, const float* g, const float* modl, int shi, int sci, bf16_t* H, int gw, int NGW, int lane_in, const bf16_t* part = nullptr, float* xwb = nullptr, const float* srcSplit = nullptr) {
    int lane = lane_in; asm volatile("" : "+v"(lane));
    for (int row0 = gw; row0 < MTOK; row0 += 2 * NGW) {
        f32x4 v[2][4]; int rows[2]; bool ok[2];
#pragma unroll
        for (int q = 0; q < 2; ++q) {
            const int row = row0 + q * NGW; rows[q] = row; ok[q] = row < MTOK;
            if (ok[q]) { const float* xr = (row < MCTX) ? srcLo + (size_t)row * D : srcHi + (size_t)(row - MCTX) * D;
                if (srcSplit != nullptr && row >= 16384) xr = srcSplit + (size_t)(row - 16384) * D;
#pragma unroll
                for (int j = 0; j < 4; ++j) v[q][j] = *(const f32x4*)(xr + 4 * lane + 256 * j); }
        }
#pragma unroll
        for (int q = 0; q < 2; ++q) {
            if (!ok[q]) continue;
            const int row = rows[q];
            if (part != nullptr && row >= 16384) {
#pragma unroll
                for (int p = 0; p < 4; ++p)
#pragma unroll
                    for (int j = 0; j < 4; ++j) { const u32x2 w = *(const u32x2*)(part + ((size_t)p * 4096 + (row - 16384)) * 1024 + 4 * lane + 256 * j);
                        v[q][j][0] += bf_lo(w.x); v[q][j][1] += bf_hi(w.x); v[q][j][2] += bf_lo(w.y); v[q][j][3] += bf_hi(w.y); }
#pragma unroll
                for (int j = 0; j < 4; ++j) *(f32x4*)(xwb + (size_t)row * D + 4 * lane + 256 * j) = v[q][j];
            }
            const int grp = row < MCTX ? 4 : ((row - MCTX) >> 12);
            const float* sh = modl + grp * 6144 + shi * 1024; const float* sc = modl + grp * 6144 + sci * 1024;
            float s = 0.f;
#pragma unroll
            for (int j = 0; j < 4; ++j) s += v[q][j][0] * v[q][j][0] + v[q][j][1] * v[q][j][1] + v[q][j][2] * v[q][j][2] + v[q][j][3] * v[q][j][3];
            const float rstd = 1.0f / sqrtf(wave_sum(s, lane) * (1.0f / D) + RMS_EPS);
#pragma unroll
            for (int j = 0; j < 4; ++j) {
                const int c = 4 * lane + 256 * j;
                const f32x4 gg = *(const f32x4*)(g + c), s1 = *(const f32x4*)(sc + c), s0 = *(const f32x4*)(sh + c);
                f32x4 y;
#pragma unroll
                for (int e = 0; e < 4; ++e) y[e] = v[q][j][e] * rstd * gg[e] * (1.0f + s1[e]) + s0[e];
                u32x2 w; w.x = cvtpk(y[0], y[1]); w.y = cvtpk(y[2], y[3]);
                *(u32x2*)(H + (size_t)row * D + c) = w;
            }
        }
    }
}

#define XB_TMO      128
#define XB_XCNT(j)  (256  + 64 * (j))
#define XB_XSUB(j)  (1280 + 64 * (j))
#define XB_XGEN(j)  (2304 + 64 * (j))
#define XB_TOP      3328
#define XB_TOPGEN   3392
#define XCD_BAR_WORDS 3456
#define XB_SPIN_CAP (1u << 18)
__device__ __forceinline__ unsigned xb_ld(unsigned* p)              { return __hip_atomic_load(p, __ATOMIC_RELAXED, __HIP_MEMORY_SCOPE_AGENT); }
__device__ __forceinline__ unsigned xb_add(unsigned* p, unsigned v) { return __hip_atomic_fetch_add(p, v, __ATOMIC_RELAXED, __HIP_MEMORY_SCOPE_AGENT); }
__device__ __forceinline__ unsigned xb_xcc_id() { return (unsigned)__builtin_amdgcn_s_getreg((3 << 11) | 20) & 0xFu; }
#define XB_SPIN(cond, bar) do { unsigned _sp = 0; while (cond) { __builtin_amdgcn_s_sleep(1); \
    if ((++_sp & 255u) == 0u) { if (xb_ld(&(bar)[XB_TMO])) break; if (_sp > XB_SPIN_CAP) { atomicAdd(&(bar)[XB_TMO], 1u); break; } } } } while (0)
struct XcdBarrier { unsigned* bar; unsigned x; volatile LAS unsigned* st; int wid; };
__device__ __forceinline__ XcdBarrier xcd_barrier_post(unsigned* bar, volatile LAS unsigned* st, int wid) {
    XcdBarrier b; b.bar = bar; b.x = xb_xcc_id(); b.st = st; b.wid = wid;
    int t0 = wid * 64 + lane_now(); asm volatile("" : "+v"(t0));
    if (t0 == 0) (void)xb_add(&bar[XB_XCNT(b.x)], 1u);
    return b;
}
__device__ __forceinline__ void xcd_barrier_complete(unsigned* bar, unsigned x, unsigned& nloc, unsigned& nx) {
    const unsigned G = gridDim.x * gridDim.y * gridDim.z;
    unsigned sum, cnt, mine, sp = 0u;
    for (;;) {
        sum = 0u; cnt = 0u; mine = 0u;
#pragma unroll
        for (unsigned j = 0; j < 16; ++j) { const unsigned c = xb_ld(&bar[XB_XCNT(j)]); sum += c; cnt += (c > 0u) ? 1u : 0u; mine = (j == x) ? c : mine; }
        if (sum == G) break;
        __builtin_amdgcn_s_sleep(1);
        if ((++sp & 255u) == 0u) { if (xb_ld(&bar[XB_TMO])) break; if (sp > XB_SPIN_CAP) { atomicAdd(&bar[XB_TMO], 1u); break; } }
    }
    nloc = mine > 0u ? mine : 1u; nx = cnt > 0u ? cnt : 1u;
}
__device__ __forceinline__ void xcd_barrier(const XcdBarrier& b) {
    asm volatile("s_waitcnt vmcnt(0)" ::: "memory");
    __syncthreads();
    int t0 = b.wid * 64 + lane_now(); asm volatile("" : "+v"(t0));
    if (t0 == 0) {
        unsigned* bar = b.bar; unsigned bx = b.x; asm volatile("" : "+s"(bar), "+s"(bx));
        __builtin_amdgcn_s_waitcnt(0);
        unsigned nloc = b.st[0], nx = b.st[1];
        if (nloc == 0u) { xcd_barrier_complete(bar, bx, nloc, nx); b.st[0] = nloc; b.st[1] = nx; }
        const unsigned old = xb_add(&bar[XB_XSUB(bx)], 1u);
        const unsigned gen = old / nloc;
        if (old + 1u == (gen + 1u) * nloc) {
            __builtin_amdgcn_fence(__ATOMIC_RELEASE, "agent");
            asm volatile("s_waitcnt vmcnt(0)" ::: "memory");
            const unsigned og = xb_add(&bar[XB_TOP], 1u);
            const unsigned tg = og / nx;
            if (og + 1u == (tg + 1u) * nx) xb_add(&bar[XB_TOPGEN], 1u);
            else XB_SPIN(xb_ld(&bar[XB_TOPGEN]) == tg, bar);
            __builtin_amdgcn_fence(__ATOMIC_ACQUIRE, "agent");
            xb_add(&bar[XB_XGEN(bx)], 1u);
            asm volatile("s_waitcnt vmcnt(0)" ::: "memory");
        } else {
            XB_SPIN(xb_ld(&bar[XB_XGEN(bx)]) == gen, bar);
            __builtin_amdgcn_fence(__ATOMIC_ACQUIRE, "agent");
            asm volatile("s_waitcnt vmcnt(0)" ::: "memory");
        }
    }
    __syncthreads();
}

constexpr int LDS_PTRS = 131072 + 1024;
__device__ __forceinline__ const float* ldsptr(LAS unsigned char* lds, int i) {
    int off = LDS_PTRS + 8 * i; asm volatile("" : "+v"(off));
    const LAS unsigned* p = (const LAS unsigned*)(lds + off);
    const unsigned lo = __builtin_amdgcn_readfirstlane(p[0]), hi = __builtin_amdgcn_readfirstlane(p[1]);
    return (const float*)(((unsigned long long)hi << 32) | lo);
}
#define AIN(k) ldsptr(lds, (k))
#define PH_RELOAD do { asm volatile("" : "+s"(gw), "+s"(bid), "+s"(G), "+s"(NGW)); ws = (unsigned char*)ldsptr(lds, 29); out = (float*)ldsptr(lds, 28); modv = (float*)(ws + WS_MOD); \
    cosM = (float*)(ws + WS_COSM); sinM = (float*)(ws + WS_SINM); cosG = (float*)(ws + WS_COSG); sinG = (float*)(ws + WS_SING); \
    HO = (bf16_t*)(ws + WS_HO); P = (bf16_t*)(ws + WS_P); QM = (bf16_t*)(ws + WS_QM); KV = (bf16_t*)(ws + WS_KV); KR = (bf16_t*)(ws + WS_KR); \
    HF = (bf16_t*)(ws + WS_HF); P2 = (bf16_t*)(ws + WS_P2); KG = (bf16_t*)(ws + WS_KG); VG = (bf16_t*)(ws + WS_VG); x_prompt = AIN(0); x_sample = AIN(1); } while (0)

__global__ void __launch_bounds__(512) fwd_kernel(KArgs args) {
    extern __shared__ __attribute__((aligned(16))) unsigned char lds_raw[];
    LAS unsigned char* lds = (LAS unsigned char*)lds_raw;
    cg::grid_group grid = cg::this_grid();
    const int wid = __builtin_amdgcn_readfirstlane((int)threadIdx.x >> 6);
#define lane0 lane_now()
#define tid0 (wid * 64 + lane_now())
    int G = gridDim.x, bid = blockIdx.x;
    int gw = bid * 8 + wid, NGW = G * 8;
    unsigned char* ws = args.ws;
    float* out = args.out;
    const float* modl = nullptr;
    float* modv = (float*)(ws + WS_MOD);
    float* cosM = (float*)(ws + WS_COSM); float* sinM = (float*)(ws + WS_SINM);
    float* cosG = (float*)(ws + WS_COSG); float* sinG = (float*)(ws + WS_SING);
    bf16_t* HO = (bf16_t*)(ws + WS_HO);
    bf16_t* P = (bf16_t*)(ws + WS_P);
    bf16_t* QM = (bf16_t*)(ws + WS_QM);
    bf16_t* KV = (bf16_t*)(ws + WS_KV);
    bf16_t* KR = (bf16_t*)(ws + WS_KR);
    bf16_t* HF = (bf16_t*)(ws + WS_HF);
    bf16_t* P2 = (bf16_t*)(ws + WS_P2);
    bf16_t* KG = (bf16_t*)(ws + WS_KG);
    bf16_t* VG = (bf16_t*)(ws + WS_VG);
    const float* x_prompt = args.in[0]; const float* x_sample = args.in[1];
    int t00 = tid0; asm volatile("" : "+v"(t00));
    if (t00 == 0) {
        LAS unsigned long long* pp = (LAS unsigned long long*)(lds + LDS_PTRS);
#pragma unroll
        for (int k = 0; k < 28; ++k) pp[k] = (unsigned long long)args.in[k];
        pp[28] = (unsigned long long)args.out; pp[29] = (unsigned long long)args.ws;
    }

    if (args.ws == nullptr) grid.sync();
    if (tid0 < 2) *(volatile LAS unsigned*)(lds + 131072 + 512 + 4 * tid0) = 0u;
    __syncthreads();
    const XcdBarrier xbar = xcd_barrier_post((unsigned*)(ws + WS_BAR), (volatile LAS unsigned*)(lds + 131072 + 512), wid);
    {
        int tid = tid0; asm volatile("" : "+v"(tid)); const int lane = tid & 63;
        int tb = 0;
        tjob(args.in[15], 1024, 2080, (bf16_t*)(ws + WS_WINA), 1, tb, lds, gw, NGW, wid, lane);
        tjob(args.in[17], 256, 768, (bf16_t*)(ws + WS_WUQ), 0, tb, lds, gw, NGW, wid, lane);
        tjob(args.in[19], 256, 1024, (bf16_t*)(ws + WS_WUKV), 0, tb, lds, gw, NGW, wid, lane);
        tjob(args.in[21], 1024, 1024, (bf16_t*)(ws + WS_WOUTA), 0, tb, lds, gw, NGW, wid, lane);
        tjob(args.in[26], 1024, 2 * DFF, (bf16_t*)(ws + WS_WF1_0), 2, tb, lds, gw, NGW, wid, lane);
        tjob(args.in[27], DFF, 1024, (bf16_t*)(ws + WS_WF2_0), 0, tb, lds, gw, NGW, wid, lane);
        { u32x4* z = (u32x4*)((bf16_t*)(ws + WS_WINA) + (size_t)2080 * 1024); const int n16 = 224 * 1024 * 2 / 16;
          for (int i = bid * 512 + tid; i < n16; i += G * 512) z[i] = (u32x4){0u, 0u, 0u, 0u}; }
        for (int i = bid * 512 + tid; i < 4096 * 80; i += G * 512) {
            int t, j, pos; float ex;
            if (i < 4096 * 16) { t = i >> 4; j = i & 15; pos = (j < 8) ? (t >> 6) : (t & 63); ex = (float)(2 * (j & 7)) * (1.0f / 16.0f); }
            else { const int i2 = i - 4096 * 16; t = i2 >> 6; j = i2 & 63; pos = (j < 32) ? (t >> 6) : (t & 63); ex = (float)(2 * (j & 31)) * (1.0f / 64.0f); }
            const float x = exp2f(-ex * 13.287712379549449f), x2 = x * x;
            float cb = 1.0f + x2 * (-0.5f + x2 * (4.1666666666666664e-2f + x2 * (-1.3888888888888889e-3f + x2 * (2.4801587301587302e-5f + x2 * (-2.7557319223985888e-7f)))));
            float sb = x * (1.0f + x2 * (-1.6666666666666666e-1f + x2 * (8.3333333333333332e-3f + x2 * (-1.9841269841269841e-4f + x2 * (2.7557319223985893e-6f + x2 * (-2.5052108385441720e-8f))))));
            float rc = 1.0f, rs = 0.0f;
#pragma unroll
            for (int bb = 0; bb < 6; ++bb) {
                if (pos & (1 << bb)) { const float tt = rc * cb - rs * sb; rs = rc * sb + rs * cb; rc = tt; }
                const float t2 = cb * cb - sb * sb; sb = 2.0f * cb * sb; cb = t2;
            }
            if (i < 4096 * 16) { cosM[i] = rc; sinM[i] = rs; } else { cosG[i - 4096 * 16] = rc; sinG[i - 4096 * 16] = rs; }
        }
        for (int j = gw; j < 1024; j += NGW) {
            const size_t row = MTOK + j;
            { const f32x4 v = *(const f32x4*)(args.in[2] + (size_t)j * 256 + 4 * lane); u32x2 w; w.x = cvtpk(v[0], v[1]); w.y = cvtpk(v[2], v[3]); *(u32x2*)(P + row * LDP + 256 + 4 * lane) = w; }
#pragma unroll
            for (int q = 0; q < 2; ++q) {
                const f32x4 v = *(const f32x4*)(args.in[4] + (size_t)j * 512 + 256 * q + 4 * lane); u32x2 w; w.x = cvtpk(v[0], v[1]); w.y = cvtpk(v[2], v[3]); *(u32x2*)(P + row * LDP + 1024 + 256 * q + 4 * lane) = w;
                const f32x4 u = *(const f32x4*)(args.in[5] + (size_t)j * 512 + 256 * q + 4 * lane); u32x2 w2; w2.x = cvtpk(u[0], u[1]); w2.y = cvtpk(u[2], u[3]); *(u32x2*)(P + row * LDP + 1536 + 256 * q + 4 * lane) = w2;
            }
            if (lane < 16) { const float v0 = args.in[3][(size_t)j * 32 + 2 * lane], v1 = args.in[3][(size_t)j * 32 + 2 * lane + 1]; *(unsigned*)(KR + row * 32 + 2 * lane) = cvtpk(v0, v1); }
        }
        __syncthreads();
        if (bid < 192) {
            const int l = bid / 96, col0 = (bid % 96) * 64;
            LAS float* scond = (LAS float*)lds;
            LAS float* red = (LAS float*)(lds + 20480);
            for (int i = tid; i < 5 * 1024; i += 512) { const int gI = i >> 10, k = i & 1023; const float x = (gI < 4) ? args.in[8][gI * 1024 + k] : args.in[9][k]; scond[i] = x / (1.0f + expf(-x)); }
            __syncthreads();
            const int cq = tid & 15, kl = tid >> 4;
            f32x4 acc[5];
#pragma unroll
            for (int gI = 0; gI < 5; ++gI) acc[gI] = (f32x4){0.f, 0.f, 0.f, 0.f};
            const float* wp = args.in[10] + (size_t)l * 1024 * 6144 + col0 + 4 * cq;
#pragma unroll 2
            for (int k = kl; k < 1024; k += 32) {
                const f32x4 w = *(const f32x4*)(wp + (size_t)k * 6144);
#pragma unroll
                for (int gI = 0; gI < 5; ++gI) acc[gI] += w * scond[gI * 1024 + k];
            }
#pragma unroll
            for (int gI = 0; gI < 5; ++gI) *(LAS f32x4*)(red + (kl * 5 + gI) * 64 + 4 * cq) = acc[gI];
            __syncthreads();
            if (tid < 320) { const int gI = tid >> 6, c = tid & 63; float s = args.in[11][l * 6144 + col0 + c];
                for (int k2 = 0; k2 < 32; ++k2) s += red[(k2 * 5 + gI) * 64 + c];
                modv[(l * 5 + gI) * 6144 + col0 + c] = s; }
            __syncthreads();
        }
    }
    xcd_barrier(xbar); PH_RELOAD;

#pragma unroll
    for (int l = 0; l < 2; ++l) {
        PH_RELOAD; modl = modv + l * 5 * 6144;
        if (l == 0) norm_mod_rows(x_prompt, x_sample, AIN(12), modl, 0, 1, HO, gw, NGW, lane0);
        else norm_mod_rows(out, out + (size_t)MCTX * D, AIN(12) + 1024, modl, 0, 1, HO, gw, NGW, lane0, (G == 256) ? (const bf16_t*)(ws + WS_PART) : nullptr, out);
        xcd_barrier(xbar); PH_RELOAD; modl = modv + l * 5 * 6144;

        if (l == 0) {
            {
                pg8::Gemm g{HO, (const bf16_t*)(ws + WS_WINA), MTOK, NINA, 1024, 1024, 1024};
                pg8::StaticOrder S; S.init(MTOK, NINA, G, bid, 1024);
                pg8::EpiInA E{P, out + O_NAK, out + O_NAV, out + O_KROPE, out + O_CKV, AIN(16), AIN(18), cosM, sinM, KR, (LAS float*)(lds + 131072 + 4096)};
                if (DBG_GM & 1) pg8::gemm_phase<pg8::EpiInA, true>(lds, g, S, E, wid);
            }
            xcd_barrier(xbar); PH_RELOAD; modl = modv + l * 5 * 6144;
            {
                pg8::Gemm g{P, (const bf16_t*)(ws + WS_WUQ), MTOK, 768, 256, LDP, 256};
                pg8::StaticOrder S; S.init(g.M, g.N, G, bid, 256);
                pg8::EpiStore E{QM, 768};
                if (DBG_GM & 2) pg8::gemm_phase<pg8::EpiStore, true>(lds, g, S, E, wid);
            }
            {
                pg8::Gemm g{P + 256, (const bf16_t*)(ws + WS_WUKV), MALL, 1024, 256, LDP, 256};
                pg8::StaticOrder S; S.init(g.M, g.N, G, bid, 256);
                pg8::EpiStore E{KV, 1024};
                if (DBG_GM & 2) pg8::gemm_phase<pg8::EpiStore, true>(lds, g, S, E, wid);
            }
            xcd_barrier(xbar); PH_RELOAD; modl = modv + l * 5 * 6144;
            {
                bf16_t* O = HO;
                const float mla_sc = 0.10206207261596575f * LOG2E, na_sc = 0.125f * LOG2E;
                int bidl = bid; asm volatile("" : "+s"(bidl));
                const bool xmap = (G == 256); const int xcd = bidl & 7, jb = bidl >> 3;
                for (int u = bidl; u < 1280; u += G) {
                    AttnArgs a{};
                    a.O = nullptr;
                    if (u < 512) {
                        const int v = jb + 32 * (u >> 8), b = xmap ? (xcd >> 1) : (u >> 7), h = xmap ? ((xcd & 1) * 4 + (v >> 4)) : ((u >> 4) & 7), qb = xmap ? (v & 15) : (u & 15);
                        a.Q = QM + h * 96; a.ldq = 768; a.Ka = KV + h * 128; a.ldka = 1024; a.Kb = KR; a.ldkb = 32; a.V = KV + h * 128 + 64; a.ldv = 1024;
                        a.O = O + h * 64; a.ldo = 1024; a.qrow0 = MCTX + b * 4096 + qb * 256; a.seg0row = MCTX + b * 4096; a.seg0n = 4096; a.seg1row = MTOK + b * 256; a.seg1n = 256;
                        a.scale_log2 = mla_sc; a.rope = 1; a.tpos0 = qb * 256; a.cosT = cosM; a.sinT = sinM;
                        attn_unit<96, 64, 8, 1, false>(lds, a, wid);
                    } else if (u < 1024) {
                        const int w = u - 512, v = jb + 32 * (w >> 8), b = xmap ? (xcd >> 1) : (w >> 7), h = xmap ? ((xcd & 1) * 4 + (v >> 4)) : ((w >> 4) & 7), qb = xmap ? (v & 15) : (w & 15), r0 = 4 * qb;
                        const int rsmin = min(max(r0 - 4, 0), 56), rsmax = min(max(r0 + 3 - 4, 0), 56), nb = rsmax + 8 - rsmin;
                        a.Q = P + 512 + h * 64; a.ldq = LDP; a.Ka = P + 1024 + h * 64; a.ldka = LDP; a.Kb = a.Ka; a.ldkb = LDP; a.V = P + 1536 + h * 64; a.ldv = LDP;
                        a.O = O + 512 + h * 64; a.ldo = 1024; a.qrow0 = MCTX + b * 4096 + qb * 256; a.seg0row = MTOK + b * 256; a.seg0n = 256; a.seg1row = MCTX + b * 4096 + rsmin * 64; a.seg1n = nb * 64;
                        a.scale_log2 = na_sc; a.rpb = AIN(20) + h * 465; a.r0 = r0; a.rsmin = rsmin;
                        attn_unit<64, 64, 8, 0, true>(lds, a, wid);
                    } else if (u < 1152) {
                        const int v = u - 1024, b = v >> 3, h = v & 7;
                        a.Q = QM + h * 96; a.ldq = 768; a.Ka = KV + h * 128; a.ldka = 1024; a.Kb = KR; a.ldkb = 32; a.V = KV + h * 128 + 64; a.ldv = 1024;
                        a.O = O + h * 64; a.ldo = 1024; a.qrow0 = b * 256; a.seg0row = b * 256; a.seg0n = 256; a.seg1row = 0; a.seg1n = 0;
                        a.scale_log2 = mla_sc; a.rope = 0; a.tpos0 = 0; a.cosT = cosM; a.sinT = sinM;
                        attn_unit<96, 64, 8, 1, false>(lds, a, wid);
                    } else {
                        const int v = u - 1152, b = v >> 3, h = v & 7;
                        a.Q = P + 512 + h * 64; a.ldq = LDP; a.Ka = P + 1024 + h * 64; a.ldka = LDP; a.Kb = a.Ka; a.ldkb = LDP; a.V = P + 1536 + h * 64; a.ldv = LDP;
                        a.O = O + 512 + h * 64; a.ldo = 1024; a.qrow0 = b * 256; a.seg0row = b * 256; a.seg0n = 256; a.seg1row = 0; a.seg1n = 0;
                        a.scale_log2 = na_sc;
                        attn_unit<64, 64, 8, 0, false>(lds, a, wid);
                    }
                }
            }
            xcd_barrier(xbar); PH_RELOAD; modl = modv + l * 5 * 6144;
        } else {
            {
                pg8::Gemm g{HO, (const bf16_t*)(ws + WS_WINC), MTOK, NINC, 1024, 1024, 1024};
                pg8::StaticOrder S; S.init(MTOK, NINC, G, bid, 1024);
                pg8::EpiInC E{P2, out + O_GV};
                if (DBG_GM & 4) pg8::gemm_phase<pg8::EpiInC, true>(lds, g, S, E, wid);
            }
            xcd_barrier(xbar); PH_RELOAD; modl = modv + l * 5 * 6144;
            int lane = lane0; asm volatile("" : "+v"(lane));
            for (int row = gw; row < MALL; row += NGW) {
                if (row < MTOK) {
                    const bf16_t* pr = P2 + (size_t)row * NINC;
#pragma unroll
                    for (int kvh = 0; kvh < 2; ++kvh) {
                        const float x1 = __uint_as_float((unsigned)pr[1024 + kvh * 128 + lane] << 16), x2 = __uint_as_float((unsigned)pr[1024 + kvh * 128 + 64 + lane] << 16);
                        const float ss = wave_sum(x1 * x1 + x2 * x2, lane);
                        const float rstd = 1.0f / sqrtf(ss * (1.0f / 128.0f) + RMS_EPS);
                        float k1 = x1 * rstd * AIN(24)[lane], k2 = x2 * rstd * AIN(24)[64 + lane];
                        if (row < MCTX) { out[O_GK + (size_t)row * 256 + kvh * 128 + lane] = k1; out[O_GK + (size_t)row * 256 + kvh * 128 + 64 + lane] = k2; }
                        else { const int t = (row - MCTX) & 4095; const float c = cosG[t * 64 + lane], s = sinG[t * 64 + lane];
                            const float n1 = k1 * c - k2 * s, n2 = k1 * s + k2 * c; k1 = n1; k2 = n2; }
                        KG[(size_t)row * 256 + kvh * 128 + lane] = (bf16_t)(cvtpk(k1, 0.f) & 0xffffu); KG[(size_t)row * 256 + kvh * 128 + 64 + lane] = (bf16_t)(cvtpk(k2, 0.f) & 0xffffu);
                    }
                    *(u32x2*)(VG + (size_t)row * 256 + 4 * lane) = *(const u32x2*)(pr + 1280 + 4 * lane);
                } else {
                    const int j = row - MTOK;
                    const f32x4 kk = *(const f32x4*)(AIN(6) + (size_t)j * 256 + 4 * lane), vv = *(const f32x4*)(AIN(7) + (size_t)j * 256 + 4 * lane);
                    u32x2 w; w.x = cvtpk(kk[0], kk[1]); w.y = cvtpk(kk[2], kk[3]); *(u32x2*)(KG + (size_t)row * 256 + 4 * lane) = w;
                    w.x = cvtpk(vv[0], vv[1]); w.y = cvtpk(vv[2], vv[3]); *(u32x2*)(VG + (size_t)row * 256 + 4 * lane) = w;
                }
            }
            xcd_barrier(xbar); PH_RELOAD; modl = modv + l * 5 * 6144;
            {
                bf16_t* O = HO;
                const float sc = 0.08838834764831845f * LOG2E;
                int bidl = bid; asm volatile("" : "+s"(bidl));
                const bool xmap = (G == 256);
                for (int u = bidl; u < 640; u += G) {
                    AttnArgs a{};
                    int h;
                    if (u < 512) { const int v = (bidl >> 3) + 32 * (u >> 8), b = xmap ? ((bidl & 7) >> 1) : (u >> 7), qb = xmap ? (v & 15) : (u & 15); h = xmap ? ((bidl & 1) * 4 + (v >> 4)) : ((u >> 4) & 7);
                        a.qrow0 = MCTX + b * 4096 + qb * 256; a.seg0row = MCTX + b * 4096; a.seg0n = 4096; a.seg1row = MTOK + b * 256; a.seg1n = 256; a.rope = 1; a.tpos0 = qb * 256;
                    } else { const int v = u - 512, b = v >> 3; h = v & 7;
                        a.qrow0 = b * 256; a.seg0row = b * 256; a.seg0n = 256; a.seg1row = 0; a.seg1n = 0; a.rope = 0; a.tpos0 = 0; }
                    a.Q = P2 + h * 128; a.ldq = NINC; a.Ka = KG + (h >> 2) * 128; a.ldka = 256; a.Kb = a.Ka; a.ldkb = 256; a.V = VG + (h >> 2) * 128; a.ldv = 256;
                    a.O = O + h * 128; a.ldo = 1024; a.scale_log2 = sc; a.cosT = cosG; a.sinT = sinG; a.qnorm = AIN(23);
                    attn_unit<128, 128, 16, 2, false>(lds, a, wid);
                }
            }
            xcd_barrier(xbar); PH_RELOAD; modl = modv + l * 5 * 6144;
        }
        {
            pg8::Gemm g{HO, (const bf16_t*)(ws + (l == 0 ? WS_WOUTA : WS_WOUTC)), MTOK, 1024, 1024, 1024, 1024};
            pg8::StaticOrder S; S.init(MTOK, 1024, G, bid, 1024, (G == 256) ? 1 : 0);
            pg8::EpiRes E{l == 0 ? x_prompt : out, l == 0 ? x_sample : out + (size_t)MCTX * D, out, modl + 2 * 1024, (bf16_t*)(ws + WS_PART)};
            if (DBG_GM & 8) pg8::gemm_phase<pg8::EpiRes, true>(lds, g, S, E, wid);
        }
        xcd_barrier(xbar); PH_RELOAD; modl = modv + l * 5 * 6144;
        norm_mod_rows(out, out + (size_t)MCTX * D, AIN(13) + l * 1024, modl, 3, 4, HO, gw, NGW, lane0, (G == 256) ? (const bf16_t*)(ws + WS_PART) : nullptr, out, (l == 0 && G == 256) ? x_sample + (size_t)(16384 - MCTX) * D : nullptr);
        if (l == 0) {
            int tb = 0;
            tjob(AIN(22), 1024, NINC, (bf16_t*)(ws + WS_WINC), 0, tb, lds, gw, NGW, wid, lane0);
            tjob(AIN(25), 1024, 1024, (bf16_t*)(ws + WS_WOUTC), 0, tb, lds, gw, NGW, wid, lane0);
            tjob(AIN(26) + (size_t)1024 * 2 * DFF, 1024, 2 * DFF, (bf16_t*)(ws + WS_WF1_1), 2, tb, lds, gw, NGW, wid, lane0);
            tjob(AIN(27) + (size_t)DFF * 1024, DFF, 1024, (bf16_t*)(ws + WS_WF2_1), 0, tb, lds, gw, NGW, wid, lane0);
        }
        xcd_barrier(xbar); PH_RELOAD; modl = modv + l * 5 * 6144;
        {
            pg8::Gemm g{HO, (const bf16_t*)(ws + (l == 0 ? WS_WF1_0 : WS_WF1_1)), MTOK, 2 * DFF, 1024, 1024, 1024};
            pg8::StaticOrder S; S.init(MTOK, 2 * DFF, G, bid, 1024);
            pg8::EpiSwiglu E{HF};
            if (DBG_GM & 16) pg8::gemm_phase<pg8::EpiSwiglu, true>(lds, g, S, E, wid);
        }
        xcd_barrier(xbar); PH_RELOAD; modl = modv + l * 5 * 6144;
        {
            pg8::Gemm g{HF, (const bf16_t*)(ws + (l == 0 ? WS_WF2_0 : WS_WF2_1)), MTOK, 1024, DFF, DFF, DFF};
            pg8::StaticOrder S; S.init(MTOK, 1024, G, bid, DFF, (G == 256) ? 1 : 0);
            pg8::EpiRes E{out, out + (size_t)MCTX * D, out, modl + 5 * 1024, (bf16_t*)(ws + WS_PART)};
            if (DBG_GM & 32) pg8::gemm_phase<pg8::EpiRes, true>(lds, g, S, E, wid);
        }
        xcd_barrier(xbar); PH_RELOAD; modl = modv + l * 5 * 6144;
    }
    PH_RELOAD;
    int lane = lane0; asm volatile("" : "+v"(lane));
    for (int row = gw; row < MTOK; row += NGW) {
        float* xr = out + (size_t)row * D;
        f32x4 v[4]; float s = 0.f;
#pragma unroll
        for (int j = 0; j < 4; ++j) v[j] = *(const f32x4*)(xr + 4 * lane + 256 * j);
        if (G == 256 && row >= 16384) {
            const bf16_t* part = (const bf16_t*)(ws + WS_PART);
#pragma unroll
            for (int p = 0; p < 4; ++p)
#pragma unroll
                for (int j = 0; j < 4; ++j) { const u32x2 w = *(const u32x2*)(part + ((size_t)p * 4096 + (row - 16384)) * 1024 + 4 * lane + 256 * j);
                    v[j][0] += bf_lo(w.x); v[j][1] += bf_hi(w.x); v[j][2] += bf_lo(w.y); v[j][3] += bf_hi(w.y); }
        }
#pragma unroll
        for (int j = 0; j < 4; ++j) s += v[j][0] * v[j][0] + v[j][1] * v[j][1] + v[j][2] * v[j][2] + v[j][3] * v[j][3];
        const float rstd = 1.0f / sqrtf(wave_sum(s, lane) * (1.0f / D) + RMS_EPS);
#pragma unroll
        for (int j = 0; j < 4; ++j) { const f32x4 gg = *(const f32x4*)(AIN(14) + 4 * lane + 256 * j); *(f32x4*)(xr + 4 * lane + 256 * j) = v[j] * rstd * gg; }
    }
}

extern "C" void kernel_launch(void* const* d_in, const int* in_sizes, int n_in, void* d_out, int out_size, void* d_ws, size_t ws_size, hipStream_t stream) {
    static int grid_blocks = 0;
    if (grid_blocks == 0) {
        if (n_in != 28 || ws_size < WS_END0) { fprintf(stderr, "kernel_launch: unexpected n_in %d / ws_size %zu\n", n_in, ws_size); grid_blocks = -1; return; }
        int dev = 0, cus = 0, per_cu = 0;
        hipGetDevice(&dev);
        hipDeviceGetAttribute(&cus, hipDeviceAttributeMultiprocessorCount, dev);
        hipFuncSetAttribute((const void*)fwd_kernel, hipFuncAttributeMaxDynamicSharedMemorySize, LDS_BYTES);
        hipOccupancyMaxActiveBlocksPerMultiprocessor(&per_cu, (const void*)fwd_kernel, 512, LDS_BYTES);
        (void)hipGetLastError();
        if (per_cu < 1) per_cu = 1;
        grid_blocks = cus * 1;
        if (grid_blocks > 256) grid_blocks = 256;
    }
    if (grid_blocks < 0) return;
    if (hipMemsetAsync((char*)d_ws + WS_BAR, 0, XCD_BAR_WORDS * 4, stream) != hipSuccess) { fprintf(stderr, "kernel_launch: memset of barrier words failed\n"); return; }
    KArgs a{};
    for (int i = 0; i < 28; ++i) a.in[i] = (const float*)d_in[i];
    a.out = (float*)d_out; a.ws = (unsigned char*)d_ws;
    void* kargs[] = {&a};
    hipError_t e = hipLaunchCooperativeKernel((const void*)fwd_kernel, dim3(grid_blocks), dim3(512), kargs, LDS_BYTES, stream);
    if (e != hipSuccess) fprintf(stderr, "cooperative launch failed: %s (grid %d)\n", hipGetErrorString(e), grid_blocks);
}
```

```cpp
#include <hip/hip_runtime.h>
#include <hip/hip_cooperative_groups.h>
#include <cstdint>
#include <cstdio>
namespace cg = cooperative_groups;

#define LAS __attribute__((address_space(3)))
typedef unsigned short bf16_t;
typedef short bf16x8 __attribute__((ext_vector_type(8)));
typedef short s16x4 __attribute__((ext_vector_type(4)));
typedef float f32x4 __attribute__((ext_vector_type(4)));
typedef float f32x16 __attribute__((ext_vector_type(16)));
typedef unsigned u32x4 __attribute__((ext_vector_type(4)));
typedef unsigned u32x2 __attribute__((ext_vector_type(2)));
typedef float f32x2_t __attribute__((ext_vector_type(2)));
typedef __bf16 bf16x2_t __attribute__((ext_vector_type(2)));

__device__ __forceinline__ unsigned cvtpk(float lo, float hi) { f32x2_t v = {lo, hi}; bf16x2_t b = __builtin_convertvector(v, bf16x2_t); return __builtin_bit_cast(unsigned, b); }
__device__ __forceinline__ float bf_lo(unsigned u) { return __uint_as_float(u << 16); }
__device__ __forceinline__ float bf_hi(unsigned u) { return __uint_as_float(u & 0xffff0000u); }
__device__ __forceinline__ int lane_now() { int r; asm volatile("v_mbcnt_lo_u32_b32 %0, -1, 0\n\tv_mbcnt_hi_u32_b32 %0, -1, %0" : "=v"(r)); return r; }
__device__ __forceinline__ float wave_sum(float v, int lane) {
#pragma unroll
    for (int o = 32; o >= 1; o >>= 1) v += __builtin_bit_cast(float, __builtin_amdgcn_ds_bpermute((lane ^ o) << 2, __builtin_bit_cast(int, v)));
    return v;
}
__device__ __forceinline__ float half_sum(float v) { auto r = __builtin_amdgcn_permlane32_swap(__float_as_uint(v), __float_as_uint(v), false, false); return __uint_as_float(r[0]) + __uint_as_float(r[1]); }
__device__ __forceinline__ float half_max(float v) { auto r = __builtin_amdgcn_permlane32_swap(__float_as_uint(v), __float_as_uint(v), false, false); return fmaxf(__uint_as_float(r[0]), __uint_as_float(r[1])); }

constexpr int D = 1024, MCTX = 4096, MLAT = 16384, MTOK = 20480, MALL = 21504;
constexpr int DFF = 2816, NINA = 2304, LDP = 2304, NINC = 1536;
constexpr float RMS_EPS = 1e-6f;
constexpr float LOG2E = 1.4426950408889634f;
constexpr size_t MiB = 1u << 20;
constexpr size_t WS_MOD = 0;
constexpr size_t WS_BAR = 512 * 1024;
constexpr size_t WS_COSM = 1 * MiB, WS_SINM = 1 * MiB + 262144, WS_COSG = 2 * MiB, WS_SING = 3 * MiB;
constexpr size_t WS_WINA = 4 * MiB;
constexpr size_t WS_WUQ = WS_WINA + 4718592;
constexpr size_t WS_WUKV = WS_WUQ + 393216;
constexpr size_t WS_WOUTA = WS_WUKV + 524288;
constexpr size_t WS_WF1_0 = WS_WOUTA + 2097152;
constexpr size_t WS_WF2_0 = WS_WF1_0 + 11534336;
constexpr size_t WS_HO = 28 * MiB;
constexpr size_t WS_BIG = 68 * MiB;
constexpr size_t WS_P = WS_BIG;
constexpr size_t WS_QM = WS_P + 99090432;
constexpr size_t WS_KV = WS_QM + 31457280;
constexpr size_t WS_KR = WS_KV + 44040192;
constexpr size_t WS_END0 = WS_KR + 1376256;
constexpr size_t WS_HF = WS_BIG;
constexpr size_t WS_W1 = WS_BIG + 112 * MiB;
constexpr size_t WS_WINC = WS_W1;
constexpr size_t WS_WOUTC = WS_WINC + 3145728;
constexpr size_t WS_WF1_1 = WS_WOUTC + 2097152;
constexpr size_t WS_WF2_1 = WS_WF1_1 + 11534336;
constexpr size_t WS_PART = WS_BIG + 134 * MiB;
constexpr size_t WS_P2 = WS_BIG;
constexpr size_t WS_KG = WS_BIG + 60 * MiB;
constexpr size_t WS_VG = WS_KG + 11010048;
static_assert(WS_WF2_0 + 5767168 <= WS_HO, "w0");
static_assert(WS_END0 <= 256 * MiB, "ws");
static_assert(WS_WF2_1 + 5767168 <= WS_PART && WS_PART + 33554432 <= WS_END0, "w1/part");
constexpr size_t O_Y = 0, O_CKV = 20971520, O_KROPE = 22020096, O_NAK = 22151168, O_NAV = 24248320, O_GK = 26345472, O_GV = 27394048;

constexpr int LDS_BYTES = 147456;
#ifndef DBG_GM
#define DBG_GM 0xff
#endif

namespace pg8 {
constexpr int BM = 256, BK = 64, HALF = 128, HTB = HALF * BK * 2, STAGE_BYTES = 8 * HTB, NXCD = 8, WGM = 8;
__host__ __device__ __forceinline__ int lds_byte(int r, int c) { const int st = (r >> 4) * 2 + (c >> 5), rr = r & 15, cc = c & 31, ob = rr * 64 + cc * 2; return st * 1024 + (ob ^ (((ob >> 9) & 1) << 5)); }
__host__ __device__ __forceinline__ void stage_rc(int b, int& R, int& C) { const int st = b / 1024, sb = b % 1024, swz = sb ^ (((sb >> 9) & 1) << 5); R = (st >> 1) * 16 + swz / 64; C = (st & 1) * 32 + (swz % 64) / 2; }
__host__ __device__ __forceinline__ int perm32(int rho) { const int n = rho >> 4, i = rho & 15; return 8 * (i >> 2) + 4 * n + (i & 3); }
struct Unit { int pm, pn, k0, nt, part; };
struct Gemm { const bf16_t* A; const bf16_t* Bt; int M, N, K, lda, ldb; };
struct StaticOrder {
    int nM, nN, nwg, G, c, K, hybrid;
    __device__ void init(int M, int N, int G_, int c_, int K_ = 0, int hybrid_ = 0) { nM = hybrid_ ? 64 : M / BM; nN = N / BM; nwg = nM * nN; G = G_; c = c_; K = K_; hybrid = hybrid_; }
    __device__ bool next(int i, Unit& u) const {
        long L = (long)i * G + c; u.k0 = 0; u.nt = K / BK; u.part = 0;
        if (hybrid) {
            if (i > 1) return false;
            if (i == 1) { const int p = c >> 6; u.part = 1 + p; u.pm = 64 + ((c & 63) >> 2); u.pn = c & 3;
                if (K == 1024) { u.nt = 4; u.k0 = 256 * p; } else { u.nt = (p < 2) ? 12 : 10; u.k0 = (p < 2) ? 768 * p : 1536 + 640 * (p - 2); }
                return true; }
        }
        if (L >= nwg) return false;
        int wgid = (int)L; { const int q = nwg / NXCD, r = nwg % NXCD, xcd = wgid % NXCD, off = wgid / NXCD; wgid = (xcd < r ? xcd * (q + 1) : r * (q + 1) + (xcd - r) * q) + off; }
        const int nig = WGM * nN, gid = wgid / nig, fm = gid * WGM, gsz = (nM - fm) < WGM ? (nM - fm) : WGM;
        u.pm = fm + ((wgid % nig) % gsz); u.pn = (wgid % nig) / gsz; return true;
    }
};
template <class Epi, bool ALIGN_EPI>
__device__ __forceinline__ void gemm_phase(LAS unsigned char* lds, const Gemm g, const StaticOrder& S, const Epi& E, const int wid_in) {
    int tid_ = wid_in * 64 + lane_now(); asm volatile("" : "+v"(tid_));
    const int tid = tid_, wid = __builtin_amdgcn_readfirstlane(tid >> 6), lane = tid & 63, wr = wid >> 2, wc = wid & 3, fr = lane & 15, fq = lane >> 4;
    unsigned voffA[2], voffB[2];
#pragma unroll
    for (int i = 0; i < 2; ++i) { int R, C; stage_rc(tid * 16 + i * 8192, R, C); const int Rb = (R & ~31) + perm32(R & 31);
        voffA[i] = (unsigned)(R * g.lda + C) * 2u; voffB[i] = (unsigned)(Rb * g.ldb + C) * 2u; }
    const size_t kstep = (size_t)(BK * 2);
    const size_t hA = (size_t)HALF * g.lda * 2, hB = (size_t)HALF * g.ldb * 2, tA = 2 * hA, tB = 2 * hB;
    const unsigned ldsw = (unsigned)wid * 1024u;
    const int aoff = lds_byte(wr * 64 + fr, fq * 8), boff = lds_byte(wc * 32 + fr, fq * 8);
#define PG8_SA(b, h) (((b) * 2 + (h)) * HTB)
#define PG8_SB(b, h) ((4 + (b) * 2 + (h)) * HTB)
#define PG8_STAGE(bufoff, gbase, voff) do { _Pragma("unroll") for (int _i = 0; _i < 2; ++_i) \
        __builtin_amdgcn_global_load_lds((const unsigned*)((const char*)(gbase) + (voff)[_i]), (LAS unsigned*)(lds + (bufoff) + ldsw + _i * 8192), 16, 0, 0); } while (0)
#define PG8_LDA(dst, b, h) do { _Pragma("unroll") for (int m = 0; m < 4; ++m) _Pragma("unroll") for (int k = 0; k < 2; ++k) dst[m][k] = *(const LAS bf16x8*)(lds + PG8_SA(b, h) + aoff + m * 2048 + k * 1024); } while (0)
#define PG8_LDB(dst, b, h) do { _Pragma("unroll") for (int n = 0; n < 2; ++n) _Pragma("unroll") for (int k = 0; k < 2; ++k) dst[n][k] = *(const LAS bf16x8*)(lds + PG8_SB(b, h) + boff + n * 2048 + k * 1024); } while (0)
#define PG8_MMA(ai, bj, At, Bt) do { __builtin_amdgcn_s_setprio(1); _Pragma("unroll") for (int m = 0; m < 4; ++m) _Pragma("unroll") for (int n = 0; n < 2; ++n) _Pragma("unroll") for (int k = 0; k < 2; ++k) \
        acc[ai][bj][m][n] = __builtin_amdgcn_mfma_f32_16x16x32_bf16(Bt[n][k], At[m][k], acc[ai][bj][m][n], 0, 0, 0); __builtin_amdgcn_s_setprio(0); } while (0)
#define PG8_WAIT_V(n) asm volatile("s_waitcnt vmcnt(" #n ")" ::: "memory")
#define PG8_WAIT_L(n) asm volatile("s_waitcnt lgkmcnt(" #n ")" ::: "memory")
#define PG8_BAR __builtin_amdgcn_s_barrier()
#define PG8_SCHED __builtin_amdgcn_sched_barrier(0)
    Unit cur, nxt; int ui = 0;
#ifdef DBG_NOGEMM
    return;
#endif
    if (!S.next(0, cur)) return;
    f32x4 acc[2][2][4][2];
#pragma unroll
    for (int a = 0; a < 2; ++a)
#pragma unroll
        for (int b = 0; b < 2; ++b)
#pragma unroll
            for (int m = 0; m < 4; ++m)
#pragma unroll
                for (int n = 0; n < 2; ++n) acc[a][b][m][n] = (f32x4){0.f, 0.f, 0.f, 0.f};
    bf16x8 At[4][2], B0[2][2], B1[2][2];
    const char* cA = (const char*)g.A + (size_t)cur.pm * tA + (size_t)cur.k0 * 2; const char* cB = (const char*)g.Bt + (size_t)cur.pn * tB + (size_t)cur.k0 * 2;
    PG8_STAGE(PG8_SB(0, 0), cB, voffB); PG8_STAGE(PG8_SB(0, 1), cB + hB, voffB); PG8_STAGE(PG8_SA(0, 0), cA, voffA); PG8_STAGE(PG8_SA(0, 1), cA + hA, voffA);
    if (wr == 1) PG8_BAR;
    PG8_WAIT_V(2); PG8_BAR;
    PG8_STAGE(PG8_SB(1, 0), cB + kstep, voffB); PG8_STAGE(PG8_SA(1, 0), cA + kstep, voffA); PG8_STAGE(PG8_SB(1, 1), cB + hB + kstep, voffB);
    PG8_WAIT_V(6); PG8_BAR;
    for (;;) {
        const bool has_next = S.next(ui + 1, nxt);
        const char* nA = has_next ? (const char*)g.A + (size_t)nxt.pm * tA + (size_t)nxt.k0 * 2 : cA; const char* nB = has_next ? (const char*)g.Bt + (size_t)nxt.pn * tB + (size_t)nxt.k0 * 2 : cB;
        const int nt = cur.nt;
#pragma unroll 1
        for (int t = 0; t < nt; t += 2) {
            const bool last = (t == nt - 2);
            const char* a1 = cA + (size_t)(t + 1) * kstep;
            const char* a2 = last ? nA : cA + (size_t)(t + 2) * kstep; const char* b2 = last ? nB : cB + (size_t)(t + 2) * kstep;
            const char* a3 = a2 + kstep; const char* b3 = b2 + kstep;
            PG8_LDB(B0, 0, 0); PG8_LDB(B1, 0, 1); PG8_SCHED; PG8_LDA(At, 0, 0); PG8_STAGE(PG8_SA(1, 1), a1 + hA, voffA);
            PG8_WAIT_V(8); PG8_WAIT_L(0); PG8_BAR; PG8_MMA(0, 0, At, B0); PG8_MMA(0, 1, At, B1); PG8_BAR; PG8_SCHED;
            PG8_LDA(At, 0, 1); PG8_STAGE(PG8_SB(0, 0), b2, voffB); PG8_STAGE(PG8_SB(0, 1), b2 + hB, voffB); PG8_STAGE(PG8_SA(0, 0), a2, voffA);
            PG8_WAIT_V(8); PG8_WAIT_L(0); PG8_BAR; PG8_MMA(1, 0, At, B0); PG8_MMA(1, 1, At, B1); PG8_BAR; PG8_SCHED;
            PG8_LDB(B0, 1, 0); PG8_LDB(B1, 1, 1); PG8_SCHED; PG8_LDA(At, 1, 0); PG8_STAGE(PG8_SA(0, 1), a2 + hA, voffA);
            PG8_WAIT_V(8); PG8_WAIT_L(0); PG8_BAR; PG8_MMA(0, 0, At, B0); PG8_MMA(0, 1, At, B1); PG8_BAR; PG8_SCHED;
            PG8_LDA(At, 1, 1); PG8_STAGE(PG8_SB(1, 0), b3, voffB); PG8_STAGE(PG8_SB(1, 1), b3 + hB, voffB); PG8_STAGE(PG8_SA(1, 0), a3, voffA);
            PG8_WAIT_V(8); PG8_WAIT_L(0); PG8_BAR; PG8_MMA(1, 0, At, B0); PG8_MMA(1, 1, At, B1); PG8_BAR; PG8_SCHED;
        }
        if constexpr (ALIGN_EPI) { if (wr == 0) PG8_BAR; }
        E(acc, cur, wr, wc, fr, fq);
        if (!has_next) break;
#pragma unroll
        for (int a = 0; a < 2; ++a)
#pragma unroll
            for (int b = 0; b < 2; ++b)
#pragma unroll
                for (int m = 0; m < 4; ++m)
#pragma unroll
                    for (int n = 0; n < 2; ++n) acc[a][b][m][n] = (f32x4){0.f, 0.f, 0.f, 0.f};
        cur = nxt; cA = nA; cB = nB; ++ui;
        if constexpr (ALIGN_EPI) { if (wr == 1) PG8_BAR; }
    }
    PG8_WAIT_V(0);
    if constexpr (!ALIGN_EPI) { if (wr == 0) PG8_BAR; }
    PG8_BAR;
#undef PG8_SA
#undef PG8_SB
#undef PG8_STAGE
#undef PG8_LDA
#undef PG8_LDB
#undef PG8_MMA
#undef PG8_WAIT_V
#undef PG8_WAIT_L
#undef PG8_BAR
#undef PG8_SCHED
}

typedef f32x4 AccT[2][2][4][2];
__device__ __forceinline__ u32x4 pack8(const f32x4 v0, const f32x4 v1) { u32x4 w; w.x = cvtpk(v0[0], v0[1]); w.y = cvtpk(v0[2], v0[3]); w.z = cvtpk(v1[0], v1[1]); w.w = cvtpk(v1[2], v1[3]); return w; }

struct EpiStore {
    bf16_t* O; int ldc;
    __device__ __forceinline__ void operator()(const AccT& acc, const Unit& u, int wr, int wc, int fr, int fq) const {
        const int row0 = u.pm * BM + wr * 64 + fr, col0 = u.pn * BM + wc * 32 + 8 * fq;
#pragma unroll
        for (int ai = 0; ai < 2; ++ai)
#pragma unroll
            for (int m = 0; m < 4; ++m) { bf16_t* rowp = O + (size_t)(row0 + ai * HALF + m * 16) * ldc + col0;
#pragma unroll
                for (int bj = 0; bj < 2; ++bj) *(u32x4*)(rowp + bj * HALF) = pack8(acc[ai][bj][m][0], acc[ai][bj][m][1]); }
    }
};
struct EpiInA {
    bf16_t* P; float* st_nk; float* st_nv; float* st_kr;
    __device__ __forceinline__ void operator()(const AccT& acc, const Unit& u, int wr, int wc, int fr, int fq) const {
        const int row0 = u.pm * BM + wr * 64 + fr, pn = u.pn, col0 = pn * BM + wc * 32 + 8 * fq;
        const bool ctx = u.pm < 16;
#pragma unroll
        for (int ai = 0; ai < 2; ++ai)
#pragma unroll
            for (int m = 0; m < 4; ++m) { const int row = row0 + ai * HALF + m * 16;
#pragma unroll
                for (int bj = 0; bj < 2; ++bj) {
                    if (pn == 8 && (bj != 0 || wc != 0)) continue;
                    const int col = col0 + bj * HALF; const f32x4 v0 = acc[ai][bj][m][0], v1 = acc[ai][bj][m][1];
                    *(u32x4*)(P + (size_t)row * LDP + col) = pack8(v0, v1);
                    if (ctx) {
                        float* d = nullptr;
                        if (pn == 4 || pn == 5) d = st_nk + (size_t)row * 512 + (col - 1024);
                        else if (pn == 6 || pn == 7) d = st_nv + (size_t)row * 512 + (col - 1536);
                        else if (pn == 8) d = st_kr + (size_t)row * 32 + (col - 2048);
                        if (d) { *(f32x4*)d = v0; *(f32x4*)(d + 4) = v1; }
                    }
                } }
    }
};
struct EpiInC {
    bf16_t* P; float* st_gv;
    __device__ __forceinline__ void operator()(const AccT& acc, const Unit& u, int wr, int wc, int fr, int fq) const {
        const int row0 = u.pm * BM + wr * 64 + fr, pn = u.pn, col0 = pn * BM + wc * 32 + 8 * fq;
        const bool st = (u.pm < 16) && (pn == 5);
#pragma unroll
        for (int ai = 0; ai < 2; ++ai)
#pragma unroll
            for (int m = 0; m < 4; ++m) { const int row = row0 + ai * HALF + m * 16;
#pragma unroll
                for (int bj = 0; bj < 2; ++bj) {
                    const int col = col0 + bj * HALF; const f32x4 v0 = acc[ai][bj][m][0], v1 = acc[ai][bj][m][1];
                    *(u32x4*)(P + (size_t)row * NINC + col) = pack8(v0, v1);
                    if (st) { float* d = st_gv + (size_t)row * 256 + (col - 1280); *(f32x4*)d = v0; *(f32x4*)(d + 4) = v1; }
                } }
    }
};
struct EpiRes {
    const float* srcLo; const float* srcHi; float* dst; const float* gate; bf16_t* part;
    __device__ __forceinline__ void operator()(const AccT& acc, const Unit& u, int wr, int wc, int fr, int fq) const {
        const int row0 = u.pm * BM + wr * 64 + fr, col0 = u.pn * BM + wc * 32 + 8 * fq;
        const int grp = u.pm < 16 ? 4 : ((u.pm - 16) >> 4);
        const float* gp = gate + grp * 6144 + col0;
        f32x4 gv[2][2];
#pragma unroll
        for (int bj = 0; bj < 2; ++bj) { gv[bj][0] = *(const f32x4*)(gp + bj * HALF); gv[bj][1] = *(const f32x4*)(gp + bj * HALF + 4); }
        const float* src = (u.pm < 16) ? srcLo : (srcHi - (size_t)MCTX * D);
#pragma unroll
        for (int ai = 0; ai < 2; ++ai)
#pragma unroll
            for (int m = 0; m < 4; ++m) { const size_t off = (size_t)(row0 + ai * HALF + m * 16) * D + col0;
#pragma unroll
                for (int bj = 0; bj < 2; ++bj) {
                    if (u.part) {
                        bf16_t* d = part + (size_t)(u.part - 1) * 4096 * 1024 + (off - (size_t)16384 * D) + bj * HALF;
                        *(u32x4*)d = pack8(gv[bj][0] * acc[ai][bj][m][0], gv[bj][1] * acc[ai][bj][m][1]);
                    } else {
                    const f32x4 x0 = *(const f32x4*)(src + off + bj * HALF), x1 = *(const f32x4*)(src + off + bj * HALF + 4);
                    *(f32x4*)(dst + off + bj * HALF) = x0 + gv[bj][0] * acc[ai][bj][m][0];
                    *(f32x4*)(dst + off + bj * HALF + 4) = x1 + gv[bj][1] * acc[ai][bj][m][1];
                    }
                } }
    }
};
struct EpiSwiglu {
    bf16_t* HF;
    __device__ __forceinline__ void operator()(const AccT& acc, const Unit& u, int wr, int wc, int fr, int fq) const {
        const int row0 = u.pm * BM + wr * 64 + fr, col0 = u.pn * HALF + wc * 32 + 8 * fq;
#pragma unroll
        for (int ai = 0; ai < 2; ++ai)
#pragma unroll
            for (int m = 0; m < 4; ++m) {
                f32x4 h[2];
#pragma unroll
                for (int n = 0; n < 2; ++n) { const f32x4 gt = acc[ai][0][m][n], up = acc[ai][1][m][n];
#pragma unroll
                    for (int e = 0; e < 4; ++e) { const float s = __builtin_amdgcn_rcpf(1.0f + __builtin_amdgcn_exp2f(-gt[e] * LOG2E)); h[n][e] = gt[e] * s * up[e]; } }
                *(u32x4*)(HF + (size_t)(row0 + ai * HALF + m * 16) * DFF + col0) = pack8(h[0], h[1]);
            }
    }
};
}

struct AttnArgs {
    const bf16_t* Q; int ldq;
    const bf16_t* Ka; int ldka; const bf16_t* Kb; int ldkb; const bf16_t* V; int ldv;
    bf16_t* O; int ldo;
    int qrow0;
    int seg0row, seg0n, seg1row, seg1n;
    float scale_log2;
    int rope; int tpos0;
    const float* cosT; const float* sinT; const float* qnorm;
    const float* rpb; int r0, rsmin;
};
__device__ __forceinline__ void glds16(const void* gsrc, unsigned lds_dst) { unsigned keep;
    asm volatile("s_mov_b32 %0, m0\n\ts_mov_b32 m0, %2\n\ts_nop 0\n\tglobal_load_lds_dwordx4 %1, off\n\ts_mov_b32 m0, %0" : "=&s"(keep) : "v"(gsrc), "s"(lds_dst) : "memory"); }
__device__ __forceinline__ float max3f(float a, float b, float c) { float r; asm("v_max3_f32 %0, %1, %2, %3" : "=v"(r) : "v"(a), "v"(b), "v"(c)); return r; }
__device__ __forceinline__ float max2f(float a, float b) { float r; asm("v_max_f32_e32 %0, %1, %2" : "=v"(r) : "v"(a), "v"(b)); return r; }
__device__ __forceinline__ int crow(int r, int hi) { return (r & 3) + 8 * (r >> 2) + 4 * hi; }

template <int DQK, int DV, int KSPLIT, int QMODE  , bool NA>
__device__ __forceinline__ void attn_unit(LAS unsigned char* lds, const AttnArgs& a, const int wid_in) {
    constexpr int KROW = (DQK > 64) ? 256 : 128, VROW = DV * 2;
    constexpr int KBUF = 64 * KROW, VBUF = 64 * VROW;
    constexpr int NKD = KBUF / 8192, NVD = VBUF / 8192;
    constexpr int ND0 = DQK / 16, NDB = DV / 32;
    constexpr int OFF_K = 0, OFF_V = 4 * KBUF, OFF_RPB = 4 * KBUF + 3 * VBUF;
    int tid_ = wid_in * 64 + lane_now(); asm volatile("" : "+v"(tid_));
    const int tid = tid_, lane = tid & 63, r32 = lane & 31, hi = lane >> 5;
    const int wid = __builtin_amdgcn_readfirstlane(tid >> 6);
    const int n0t = a.seg0n >> 6, NT = n0t + (a.seg1n >> 6);

    const bf16_t* kp[NKD]; int kst[NKD]; const bf16_t* vp[NVD];
#pragma unroll
    for (int i = 0; i < NKD; ++i) {
        int row, c;
        if (KROW == 256) { row = 8 * wid + 4 * i + (lane >> 4); c = (lane & 15) ^ (row & 15); }
        else { row = 8 * wid + (lane >> 3); c = (lane & 7) ^ ((row >> 1) & 7); }
        if (c >= DQK / 8) c = 0;
        if (c < KSPLIT) { kp[i] = a.Ka + (size_t)row * a.ldka + c * 8; kst[i] = a.ldka; }
        else { kp[i] = a.Kb + (size_t)row * a.ldkb + (c - KSPLIT) * 8; kst[i] = a.ldkb; }
    }
#pragma unroll
    for (int i = 0; i < NVD; ++i) {
        int row, c;
        if (VROW == 256) { row = 8 * wid + 4 * i + (lane >> 4); c = (lane & 15) ^ (4 * (row & 3)); }
        else { row = 8 * wid + (lane >> 3); c = (lane & 7) ^ (4 * ((row >> 1) & 1)); }
        vp[i] = a.V + (size_t)row * a.ldv + c * 8;
    }
    const unsigned lds0 = (unsigned)(uintptr_t)lds;
    auto tile_rb = [&](int t) { t = t < NT ? t : NT - 1; return (t < n0t) ? (a.seg0row + 64 * t) : (a.seg1row + 64 * (t - n0t)); };
    auto issueK = [&](int t, int slot) {
        const int rb = tile_rb(t);
#pragma unroll
        for (int i = 0; i < NKD; ++i)
            glds16(kp[i] + (size_t)rb * kst[i], (unsigned)__builtin_amdgcn_readfirstlane((int)(lds0 + OFF_K + slot * KBUF + (wid * NKD + i) * 1024)));
    };
    auto issueV = [&](int t, int slot) {
        const int rb = tile_rb(t);
#pragma unroll
        for (int i = 0; i < NVD; ++i)
            glds16(vp[i] + (size_t)rb * a.ldv, (unsigned)__builtin_amdgcn_readfirstlane((int)(lds0 + OFF_V + slot * VBUF + (wid * NVD + i) * 1024)));
    };

    issueK(0, 0); issueV(0, 0); issueK(1, 1); issueV(1, 1); issueK(2, 2);
    if (NA) { for (int i = tid; i < 465; i += 512) *(LAS float*)(lds + OFF_RPB + i * 4) = a.rpb[i] * LOG2E; }

    const int qrow = a.qrow0 + wid * 32 + r32;
    bf16x8 qf[ND0];
    {
        const bf16_t* qp = a.Q + (size_t)qrow * a.ldq + hi * 8;
        u32x4 qraw[ND0];
#pragma unroll
        for (int d0 = 0; d0 < ND0; ++d0) qraw[d0] = *(const u32x4*)(qp + d0 * 16);
        if (QMODE == 1) {
            if (a.rope) {
                const int tpos = a.tpos0 + wid * 32 + r32;
                const float* cp = a.cosT + (size_t)tpos * 16 + hi * 8; const float* sp = a.sinT + (size_t)tpos * 16 + hi * 8;
                const f32x4 c0 = *(const f32x4*)cp, c1 = *(const f32x4*)(cp + 4), s0 = *(const f32x4*)sp, s1 = *(const f32x4*)(sp + 4);
                float cc[8] = {c0[0], c0[1], c0[2], c0[3], c1[0], c1[1], c1[2], c1[3]}, ss[8] = {s0[0], s0[1], s0[2], s0[3], s1[0], s1[1], s1[2], s1[3]};
                u32x4 y1, y2;
#pragma unroll
                for (int w = 0; w < 4; ++w) {
                    const float a0 = bf_lo(qraw[4][w]), a1 = bf_hi(qraw[4][w]), b0 = bf_lo(qraw[5][w]), b1 = bf_hi(qraw[5][w]);
                    y1[w] = cvtpk(a0 * cc[2 * w] - b0 * ss[2 * w], a1 * cc[2 * w + 1] - b1 * ss[2 * w + 1]);
                    y2[w] = cvtpk(a0 * ss[2 * w] + b0 * cc[2 * w], a1 * ss[2 * w + 1] + b1 * cc[2 * w + 1]);
                }
                qraw[4] = y1; qraw[5] = y2;
            }
        }
        if (QMODE == 2) {
            float ssq = 0.f;
#pragma unroll
            for (int d0 = 0; d0 < ND0; ++d0)
#pragma unroll
                for (int w = 0; w < 4; ++w) { const float x0 = bf_lo(qraw[d0][w]), x1 = bf_hi(qraw[d0][w]); ssq += x0 * x0 + x1 * x1; }
            ssq = half_sum(ssq);
            const float rstd = a.scale_log2 / sqrtf(ssq * (1.0f / 128.0f) + RMS_EPS);
            const int tpos = a.tpos0 + wid * 32 + r32;
#pragma unroll
            for (int d0 = 0; d0 < 4; ++d0) {
                const float* g1 = a.qnorm + 16 * d0 + 8 * hi; const float* g2 = g1 + 64;
                const float* cp = a.cosT + (size_t)tpos * 64 + 16 * d0 + 8 * hi; const float* sp = a.sinT + (size_t)tpos * 64 + 16 * d0 + 8 * hi;
                f32x4 cv[2] = {(f32x4){1.f, 1.f, 1.f, 1.f}, (f32x4){1.f, 1.f, 1.f, 1.f}}, sv[2] = {(f32x4){0.f, 0.f, 0.f, 0.f}, (f32x4){0.f, 0.f, 0.f, 0.f}};
                if (a.rope) { cv[0] = *(const f32x4*)cp; cv[1] = *(const f32x4*)(cp + 4); sv[0] = *(const f32x4*)sp; sv[1] = *(const f32x4*)(sp + 4); }
                u32x4 y1, y2;
#pragma unroll
                for (int w = 0; w < 4; ++w) {
                    float a0 = bf_lo(qraw[d0][w]) * rstd * g1[2 * w], a1 = bf_hi(qraw[d0][w]) * rstd * g1[2 * w + 1];
                    float b0 = bf_lo(qraw[d0 + 4][w]) * rstd * g2[2 * w], b1 = bf_hi(qraw[d0 + 4][w]) * rstd * g2[2 * w + 1];
                    if (a.rope) {
                        const float c0 = cv[w >> 1][(2 * w) & 3], c1 = cv[w >> 1][(2 * w + 1) & 3], s0 = sv[w >> 1][(2 * w) & 3], s1 = sv[w >> 1][(2 * w + 1) & 3];
                        const float n0 = a0 * c0 - b0 * s0, n1 = a1 * c1 - b1 * s1, m0 = a0 * s0 + b0 * c0, m1 = a1 * s1 + b1 * c1;
                        a0 = n0; a1 = n1; b0 = m0; b1 = m1;
                    }
                    y1[w] = cvtpk(a0, a1); y2[w] = cvtpk(b0, b1);
                }
                qraw[d0] = y1; qraw[d0 + 4] = y2;
            }
        }
        if (QMODE != 2) {
#pragma unroll
            for (int d0 = 0; d0 < ND0; ++d0)
#pragma unroll
                for (int w = 0; w < 4; ++w) qraw[d0][w] = cvtpk(bf_lo(qraw[d0][w]) * a.scale_log2, bf_hi(qraw[d0][w]) * a.scale_log2);
        }
#pragma unroll
        for (int d0 = 0; d0 < ND0; ++d0) qf[d0] = __builtin_bit_cast(bf16x8, qraw[d0]);
    }

    f32x16 o[NDB];
#pragma unroll
    for (int i = 0; i < NDB; ++i) o[i] = f32x16{};
    constexpr bool NEGC = (DV == 64);
    float m_run = NEGC ? 0.f : -1e30f, l_run = 0.f;
    f32x16 negm16 = f32x16{};

    const int qr = NA ? (a.r0 + (wid >> 1)) : 0;
    const int qc = NA ? ((wid & 1) * 32 + r32) : 0;
    const int rs = NA ? min(max(qr - 4, 0), 56) : 0;
    const int cs = NA ? min(max(qc - 8, 0), 48) : 0;

    const int ksw = (KROW == 256) ? (r32 & 15) : ((r32 >> 1) & 7);
    const int ke = hi ^ ksw;
    const LAS unsigned char* krow = lds + OFF_K + r32 * KROW;
    auto qk = [&](int slot, f32x16& p0, f32x16& p1, const f32x16& cinit) {
        const LAS unsigned char* kb = krow + slot * KBUF;
#pragma unroll
        for (int d0 = 0; d0 < ND0; ++d0) {
            const int co = ((2 * d0) ^ ke) * 16;
            const bf16x8 k0 = *(const LAS bf16x8*)(kb + co);
            const bf16x8 k1 = *(const LAS bf16x8*)(kb + 32 * KROW + co);
            p0 = __builtin_amdgcn_mfma_f32_32x32x16_bf16(k0, qf[d0], d0 == 0 ? cinit : p0, 0, 0, 0);
            p1 = __builtin_amdgcn_mfma_f32_32x32x16_bf16(k1, qf[d0], d0 == 0 ? cinit : p1, 0, 0, 0);
        }
    };
    const int q4 = (lane & 15) >> 2, pp = lane & 3, blk = (lane >> 4) & 1;
    const int vsw = (VROW == 256) ? q4 : ((q4 >> 1) & 1);
    const int vlane_off = (4 * hi + q4) * VROW + 32 * blk + 8 * pp;
    constexpr float THR = 8.0f;
#define ATT_WAIT_BAR(N) do { asm volatile("s_waitcnt vmcnt(%0) lgkmcnt(0)" :: "n"(N) : "memory"); __builtin_amdgcn_s_barrier(); asm volatile("" ::: "memory"); } while (0)

    ATT_WAIT_BAR(2 * NKD + 2 * NVD);
    f32x16 p0, p1, n0, n1;
    qk(0, p0, p1, negm16);
    auto na_skip = [&](int t) { if (!NA || t < n0t || t >= NT) return false; const int kr = a.rsmin + (t - n0t); return (kr < rs) || (kr >= rs + 8); };
    int ks1 = 1, ks3 = 3, vs0 = 0, vs2 = 2;
    auto step = [&](int t, f32x16& p0, f32x16& p1, f32x16& n0, f32x16& n1) {
        ATT_WAIT_BAR(NKD + NVD);
        issueK(t + 3, ks3); issueV(t + 2, vs2);
        constexpr int HA = ND0 / 2;
        bf16x8 kA0[HA], kA1[HA];
        const LAS unsigned char* kbn = krow + ks1 * KBUF;
        if (!NA) {
#pragma unroll
            for (int d0 = 0; d0 < HA; ++d0) { const int co = ((2 * d0) ^ ke) * 16; kA0[d0] = *(const LAS bf16x8*)(kbn + co); kA1[d0] = *(const LAS bf16x8*)(kbn + 32 * KROW + co); }
            __builtin_amdgcn_sched_barrier(0);
        }
        const bool skip = na_skip(t);
        if (!skip) {
            if (NA && t >= n0t) {
                const int kr = a.rsmin + (t - n0t);
                const LAS float* bt = (const LAS float*)(lds + OFF_RPB) + (kr - qr + 7) * 31;
#pragma unroll
                for (int r = 0; r < 16; ++r) {
                    const int kc0 = crow(r, hi), kc1 = kc0 + 32;
                    const bool v0 = (kc0 >= cs) && (kc0 < cs + 16), v1 = (kc1 >= cs) && (kc1 < cs + 16);
                    const int i0 = min(max(kc0 - qc + 15, 0), 30), i1 = min(max(kc1 - qc + 15, 0), 30);
                    const float b0 = bt[i0], b1 = bt[i1];
                    p0[r] = v0 ? (p0[r] + b0) : -1e30f;
                    p1[r] = v1 ? (p1[r] + b1) : -1e30f;
                }
            }
            float mx = max2f(p0[0], p1[0]), mx2 = max2f(p0[1], p1[1]);
#pragma unroll
            for (int r = 2; r < 16; r += 2) { mx = max3f(mx, p0[r], p1[r]); mx2 = max3f(mx2, p0[r + 1], p1[r + 1]); }
            mx = max2f(mx, mx2);
            mx = half_max(mx);
            float negm = 0.f;
            if (NEGC) {
                if (t == 0 || __any(mx > THR)) {
                    const float dl = (t == 0) ? mx : fmaxf(mx, 0.f);
                    m_run += dl;
#pragma unroll
                    for (int r = 0; r < 16; ++r) { p0[r] -= dl; p1[r] -= dl; }
                    if (t != 0) {
                        const float f = __builtin_amdgcn_exp2f(-dl);
                        l_run *= f;
#pragma unroll
                        for (int i = 0; i < NDB; ++i)
#pragma unroll
                            for (int r = 0; r < 16; ++r) o[i][r] *= f;
                    }
#pragma unroll
                    for (int r = 0; r < 16; ++r) negm16[r] = -m_run;
                }
            } else {
                if (__any(mx > m_run + THR)) {
                    const float m_new = max2f(m_run, mx);
                    const float alpha = __builtin_amdgcn_exp2f(m_run - m_new);
                    m_run = m_new; l_run *= alpha;
#pragma unroll
                    for (int i = 0; i < NDB; ++i)
#pragma unroll
                        for (int r = 0; r < 16; ++r) o[i][r] *= alpha;
                }
                negm = -m_run;
            }
            if (!NA) {
#pragma unroll
                for (int d0 = 0; d0 < HA; ++d0) {
                    n0 = __builtin_amdgcn_mfma_f32_32x32x16_bf16(kA0[d0], qf[d0], d0 == 0 ? negm16 : n0, 0, 0, 0);
                    n1 = __builtin_amdgcn_mfma_f32_32x32x16_bf16(kA1[d0], qf[d0], d0 == 0 ? negm16 : n1, 0, 0, 0);
                }
                bf16x8 kB0[ND0 - HA], kB1[ND0 - HA];
#pragma unroll
                for (int d0 = HA; d0 < ND0; ++d0) { const int co = ((2 * d0) ^ ke) * 16; kB0[d0 - HA] = *(const LAS bf16x8*)(kbn + co); kB1[d0 - HA] = *(const LAS bf16x8*)(kbn + 32 * KROW + co); }
#pragma unroll
                for (int d0 = HA; d0 < ND0; ++d0) {
                    n0 = __builtin_amdgcn_mfma_f32_32x32x16_bf16(kB0[d0 - HA], qf[d0], n0, 0, 0, 0);
                    n1 = __builtin_amdgcn_mfma_f32_32x32x16_bf16(kB1[d0 - HA], qf[d0], n1, 0, 0, 0);
                }
            } else {
                if (!na_skip(t + 1)) qk(ks1, n0, n1, negm16);
            }
            {
                f32x2_t sum2 = {0.f, 0.f};
#pragma unroll
                for (int r = 0; r < 16; r += 2) {
                    f32x2_t a2 = {p0[r], p0[r + 1]}, b2 = {p1[r], p1[r + 1]};
                    if (!NEGC) { const f32x2_t nm2 = {negm, negm}; a2 += nm2; b2 += nm2; }
                    a2.x = __builtin_amdgcn_exp2f(a2.x); a2.y = __builtin_amdgcn_exp2f(a2.y); b2.x = __builtin_amdgcn_exp2f(b2.x); b2.y = __builtin_amdgcn_exp2f(b2.y);
                    sum2 += a2; sum2 += b2;
                    p0[r] = a2.x; p0[r + 1] = a2.y; p1[r] = b2.x; p1[r + 1] = b2.y;
                }
                l_run += sum2.x + sum2.y;
            }
            bf16x8 pa[4];
            {
                u32x4 w;
                w.x = cvtpk(p0[0], p0[1]); w.y = cvtpk(p0[2], p0[3]); w.z = cvtpk(p0[4], p0[5]); w.w = cvtpk(p0[6], p0[7]); pa[0] = __builtin_bit_cast(bf16x8, w);
                w.x = cvtpk(p0[8], p0[9]); w.y = cvtpk(p0[10], p0[11]); w.z = cvtpk(p0[12], p0[13]); w.w = cvtpk(p0[14], p0[15]); pa[1] = __builtin_bit_cast(bf16x8, w);
                w.x = cvtpk(p1[0], p1[1]); w.y = cvtpk(p1[2], p1[3]); w.z = cvtpk(p1[4], p1[5]); w.w = cvtpk(p1[6], p1[7]); pa[2] = __builtin_bit_cast(bf16x8, w);
                w.x = cvtpk(p1[8], p1[9]); w.y = cvtpk(p1[10], p1[11]); w.z = cvtpk(p1[12], p1[13]); w.w = cvtpk(p1[14], p1[15]); pa[3] = __builtin_bit_cast(bf16x8, w);
            }
            const LAS unsigned char* vb = lds + OFF_V + vs0 * VBUF + vlane_off;
#pragma unroll
            for (int ks = 0; ks < 4; ++ks)
#pragma unroll
                for (int db = 0; db < NDB; ++db) {
                    const LAS unsigned char* vq = vb + (16 * ks) * VROW + ((db ^ vsw) * 64);
                    const s16x4 lo = __builtin_bit_cast(s16x4, __builtin_amdgcn_ds_read_tr16_b64_v4i16((LAS s16x4*)(vq)));
                    const s16x4 hh = __builtin_bit_cast(s16x4, __builtin_amdgcn_ds_read_tr16_b64_v4i16((LAS s16x4*)(vq + 8 * VROW)));
                    const bf16x8 vf = (bf16x8){lo[0], lo[1], lo[2], lo[3], hh[0], hh[1], hh[2], hh[3]};
                    o[db] = __builtin_amdgcn_mfma_f32_32x32x16_bf16(vf, pa[ks], o[db], 0, 0, 0);
                }
        } else { if (NA && !na_skip(t + 1)) qk(ks1, n0, n1, negm16); }
        ks1 = (ks1 + 1) & 3; ks3 = (ks3 + 1) & 3; vs0 = (vs0 == 2) ? 0 : vs0 + 1; vs2 = (vs2 == 2) ? 0 : vs2 + 1;
    };
    {
        int t = 0;
        for (; t + 1 < NT; t += 2) { step(t, p0, p1, n0, n1); step(t + 1, n0, n1, p0, p1); }
        if (t < NT) step(t, p0, p1, n0, n1);
    }
    const float lt = half_sum(l_run);
    const float inv = 1.0f / lt;
    ATT_WAIT_BAR(0);
    {
        constexpr int OP = DV * 2 + 8;
        int lane2 = lane; asm volatile("" : "+v"(lane2));
        const int e32 = lane2 & 31, ehi = lane2 >> 5;
        LAS unsigned char* stg = lds + wid * (32 * OP);
#pragma unroll
        for (int db = 0; db < NDB; ++db)
#pragma unroll
            for (int r4 = 0; r4 < 4; ++r4) {
                u32x2 w; w.x = cvtpk(o[db][4 * r4] * inv, o[db][4 * r4 + 1] * inv); w.y = cvtpk(o[db][4 * r4 + 2] * inv, o[db][4 * r4 + 3] * inv);
                *(LAS u32x2*)(stg + e32 * OP + (32 * db + 8 * r4 + 4 * ehi) * 2) = w;
            }
        constexpr int CH = DV / 8, RPI = 64 / CH;
        bf16_t* ob = a.O + (size_t)(a.qrow0 + wid * 32) * a.ldo;
#pragma unroll
        for (int i = 0; i < 32 / RPI; ++i) {
            const int row = i * RPI + lane2 / CH, ch = lane2 % CH;
            const u32x2 lo = *(const LAS u32x2*)(stg + row * OP + ch * 16), hh = *(const LAS u32x2*)(stg + row * OP + ch * 16 + 8);
            *(u32x4*)(ob + (size_t)row * a.ldo + ch * 8) = (u32x4){lo.x, lo.y, hh.x, hh.y};
        }
    }
    ATT_WAIT_BAR(0);
#undef ATT_WAIT_BAR
}

struct KArgs { const float* in[28]; float* out; unsigned char* ws; };

__device__ __forceinline__ void transpose_item(const float* W, int K, int N, bf16_t* WT, int mapmode, LAS float* scr, int item, int lane) {
    const int nblk = N / 32, kb = item / nblk, nb = item % nblk, k0 = 64 * kb, n0 = 32 * nb;
    int d0 = n0;
    if (mapmode == 1) {
        if (n0 < 512) d0 = n0; else if (n0 < 544) d0 = 2048 + (n0 - 512); else d0 = n0 - 32;
    } else if (mapmode == 2) {
        if (n0 < DFF) d0 = (n0 >> 7) * 256 + (n0 & 127); else { const int j = n0 - DFF; d0 = (j >> 7) * 256 + 128 + (j & 127); }
    }
#pragma unroll 8
    for (int i = 0; i < 32; ++i) { const int kk = 2 * i + (lane >> 5); scr[kk * 33 + (lane & 31)] = W[(size_t)(k0 + kk) * N + n0 + (lane & 31)]; }
    asm volatile("s_waitcnt lgkmcnt(0)" ::: "memory");
    const int c = lane & 7;
#pragma unroll
    for (int j = 0; j < 4; ++j) { const int n = (lane >> 3) + 8 * j; const LAS float* s = scr + (8 * c) * 33 + n;
        u32x4 o; o.x = cvtpk(s[0 * 33], s[1 * 33]); o.y = cvtpk(s[2 * 33], s[3 * 33]); o.z = cvtpk(s[4 * 33], s[5 * 33]); o.w = cvtpk(s[6 * 33], s[7 * 33]);
        *(u32x4*)(WT + (size_t)(d0 + n) * K + k0 + 8 * c) = o; }
    asm volatile("s_waitcnt lgkmcnt(0)" ::: "memory");
}

__device__ __forceinline__ void tjob(const float* W, int K, int N, bf16_t* WT, int map, int& base, LAS unsigned char* lds, int gw, int NGW, int wid, int lane) {
    asm volatile("" : "+v"(lane));
    LAS float* scr = (LAS float*)(lds + wid * 16384);
    const int items = (K / 64) * (N / 32);
    const int first = ((gw - base) % NGW + NGW) % NGW;
    for (int it = first; it < items; it += NGW) transpose_item(W, K, N, WT, map, scr, it, lane);
    base += items;
}

__device__ __forceinline__ void norm_mod_rows(const float* srcLo, const float* srcHi, const float* g, const float* modl, int shi, int sci, bf16_t* H, int gw, int NGW, int lane_in, const bf16_t* part = nullptr, float* xwb = nullptr, const float* srcSplit = nullptr) {
    int lane = lane_in; asm volatile("" : "+v"(lane));
    for (int row0 = gw; row0 < MTOK; row0 += 2 * NGW) {
        f32x4 v[2][4]; int rows[2]; bool ok[2];
#pragma unroll
        for (int q = 0; q < 2; ++q) {
            const int row = row0 + q * NGW; rows[q] = row; ok[q] = row < MTOK;
            if (ok[q]) { const float* xr = (row < MCTX) ? srcLo + (size_t)row * D : srcHi + (size_t)(row - MCTX) * D;
                if (srcSplit != nullptr && row >= 16384) xr = srcSplit + (size_t)(row - 16384) * D;
#pragma unroll
                for (int j = 0; j < 4; ++j) v[q][j] = *(const f32x4*)(xr + 4 * lane + 256 * j); }
        }
#pragma unroll
        for (int q = 0; q < 2; ++q) {
            if (!ok[q]) continue;
            const int row = rows[q];
            if (part != nullptr && row >= 16384) {
#pragma unroll
                for (int p = 0; p < 4; ++p)
#pragma unroll
                    for (int j = 0; j < 4; ++j) { const u32x2 w = *(const u32x2*)(part + ((size_t)p * 4096 + (row - 16384)) * 1024 + 4 * lane + 256 * j);
                        v[q][j][0] += bf_lo(w.x); v[q][j][1] += bf_hi(w.x); v[q][j][2] += bf_lo(w.y); v[q][j][3] += bf_hi(w.y); }
#pragma unroll
                for (int j = 0; j < 4; ++j) *(f32x4*)(xwb + (size_t)row * D + 4 * lane + 256 * j) = v[q][j];
            }
            const int grp = row < MCTX ? 4 : ((row - MCTX) >> 12);
            const float* sh = modl + grp * 6144 + shi * 1024; const float* sc = modl + grp * 6144 + sci * 1024;
            float s = 0.f;
#pragma unroll
            for (int j = 0; j < 4; ++j) s += v[q][j][0] * v[q][j][0] + v[q][j][1] * v[q][j][1] + v[q][j][2] * v[q][j][2] + v[q][j][3] * v[q][j][3];
            const float rstd = 1.0f / sqrtf(wave_sum(s, lane) * (1.0f / D) + RMS_EPS);
#pragma unroll
            for (int j = 0; j < 4; ++j) {
                const int c = 4 * lane + 256 * j;
                const f32x4 gg = *(const f32x4*)(g + c), s1 = *(const f32x4*)(sc + c), s0 = *(const f32x4*)(sh + c);
                f32x4 y;
#pragma unroll
                for (int e = 0; e < 4; ++e) y[e] = v[q][j][e] * rstd * gg[e] * (1.0f + s1[e]) + s0[e];
                u32x2 w; w.x = cvtpk(y[0], y[1]); w.y = cvtpk(y[2], y[3]);
                *(u32x2*)(H + (size_t)row * D + c) = w;
            }
        }
    }
}

#define XB_TMO      128
#define XB_XCNT(j)  (256  + 64 * (j))
#define XB_XSUB(j)  (1280 + 64 * (j))
#define XB_XGEN(j)  (2304 + 64 * (j))
#define XB_TOP      3328
#define XB_TOPGEN   3392
#define XCD_BAR_WORDS 3456
#define XB_SPIN_CAP (1u << 18)
__device__ __forceinline__ unsigned xb_ld(unsigned* p)              { return __hip_atomic_load(p, __ATOMIC_RELAXED, __HIP_MEMORY_SCOPE_AGENT); }
__device__ __forceinline__ unsigned xb_add(unsigned* p, unsigned v) { return __hip_atomic_fetch_add(p, v, __ATOMIC_RELAXED, __HIP_MEMORY_SCOPE_AGENT); }
__device__ __forceinline__ unsigned xb_xcc_id() { return (unsigned)__builtin_amdgcn_s_getreg((3 << 11) | 20) & 0xFu; }
#define XB_SPIN(cond, bar) do { unsigned _sp = 0; while (cond) { __builtin_amdgcn_s_sleep(1); \
    if ((++_sp & 255u) == 0u) { if (xb_ld(&(bar)[XB_TMO])) break; if (_sp > XB_SPIN_CAP) { atomicAdd(&(bar)[XB_TMO], 1u); break; } } } } while (0)
struct XcdBarrier { unsigned* bar; unsigned x; volatile LAS unsigned* st; int wid; };
__device__ __forceinline__ XcdBarrier xcd_barrier_post(unsigned* bar, volatile LAS unsigned* st, int wid) {
    XcdBarrier b; b.bar = bar; b.x = xb_xcc_id(); b.st = st; b.wid = wid;
    int t0 = wid * 64 + lane_now(); asm volatile("" : "+v"(t0));
    if (t0 == 0) (void)xb_add(&bar[XB_XCNT(b.x)], 1u);
    return b;
}
__device__ __forceinline__ void xcd_barrier_complete(unsigned* bar, unsigned x, unsigned& nloc, unsigned& nx) {
    const unsigned G = gridDim.x * gridDim.y * gridDim.z;
    unsigned sum, cnt, mine, sp = 0u;
    for (;;) {
        sum = 0u; cnt = 0u; mine = 0u;
#pragma unroll
        for (unsigned j = 0; j < 16; ++j) { const unsigned c = xb_ld(&bar[XB_XCNT(j)]); sum += c; cnt += (c > 0u) ? 1u : 0u; mine = (j == x) ? c : mine; }
        if (sum == G) break;
        __builtin_amdgcn_s_sleep(1);
        if ((++sp & 255u) == 0u) { if (xb_ld(&bar[XB_TMO])) break; if (sp > XB_SPIN_CAP) { atomicAdd(&bar[XB_TMO], 1u); break; } }
    }
    nloc = mine > 0u ? mine : 1u; nx = cnt > 0u ? cnt : 1u;
}
__device__ __forceinline__ void xcd_barrier(const XcdBarrier& b) {
    asm volatile("s_waitcnt vmcnt(0)" ::: "memory");
    __syncthreads();
    int t0 = b.wid * 64 + lane_now(); asm volatile("" : "+v"(t0));
    if (t0 == 0) {
        unsigned* bar = b.bar; unsigned bx = b.x; asm volatile("" : "+s"(bar), "+s"(bx));
        __builtin_amdgcn_s_waitcnt(0);
        unsigned nloc = b.st[0], nx = b.st[1];
        if (nloc == 0u) { xcd_barrier_complete(bar, bx, nloc, nx); b.st[0] = nloc; b.st[1] = nx; }
        const unsigned old = xb_add(&bar[XB_XSUB(bx)], 1u);
        const unsigned gen = old / nloc;
        if (old + 1u == (gen + 1u) * nloc) {
            __builtin_amdgcn_fence(__ATOMIC_RELEASE, "agent");
            asm volatile("s_waitcnt vmcnt(0)" ::: "memory");
            const unsigned og = xb_add(&bar[XB_TOP], 1u);
            const unsigned tg = og / nx;
            if (og + 1u == (tg + 1u) * nx) xb_add(&bar[XB_TOPGEN], 1u);
            else XB_SPIN(xb_ld(&bar[XB_TOPGEN]) == tg, bar);
            __builtin_amdgcn_fence(__ATOMIC_ACQUIRE, "agent");
            xb_add(&bar[XB_XGEN(bx)], 1u);
            asm volatile("s_waitcnt vmcnt(0)" ::: "memory");
        } else {
            XB_SPIN(xb_ld(&bar[XB_XGEN(bx)]) == gen, bar);
            __builtin_amdgcn_fence(__ATOMIC_ACQUIRE, "agent");
            asm volatile("s_waitcnt vmcnt(0)" ::: "memory");
        }
    }
    __syncthreads();
}

constexpr int LDS_PTRS = 131072 + 1024;
__device__ __forceinline__ const float* ldsptr(LAS unsigned char* lds, int i) {
    int off = LDS_PTRS + 8 * i; asm volatile("" : "+v"(off));
    const LAS unsigned* p = (const LAS unsigned*)(lds + off);
    const unsigned lo = __builtin_amdgcn_readfirstlane(p[0]), hi = __builtin_amdgcn_readfirstlane(p[1]);
    return (const float*)(const __attribute__((address_space(1))) float*)(((unsigned long long)hi << 32) | lo);
}
#define AIN(k) ldsptr(lds, (k))
#define PH_RELOAD do { asm volatile("" : "+s"(gw), "+s"(bid), "+s"(G), "+s"(NGW)); ws = (unsigned char*)ldsptr(lds, 29); out = (float*)ldsptr(lds, 28); modv = (float*)(ws + WS_MOD); \
    cosM = (float*)(ws + WS_COSM); sinM = (float*)(ws + WS_SINM); cosG = (float*)(ws + WS_COSG); sinG = (float*)(ws + WS_SING); \
    HO = (bf16_t*)(ws + WS_HO); P = (bf16_t*)(ws + WS_P); QM = (bf16_t*)(ws + WS_QM); KV = (bf16_t*)(ws + WS_KV); KR = (bf16_t*)(ws + WS_KR); \
    HF = (bf16_t*)(ws + WS_HF); P2 = (bf16_t*)(ws + WS_P2); KG = (bf16_t*)(ws + WS_KG); VG = (bf16_t*)(ws + WS_VG); x_prompt = AIN(0); x_sample = AIN(1); } while (0)

__global__ void __launch_bounds__(512) fwd_kernel(KArgs args) {
    extern __shared__ __attribute__((aligned(16))) unsigned char lds_raw[];
    LAS unsigned char* lds = (LAS unsigned char*)lds_raw;
    cg::grid_group grid = cg::this_grid();
    const int wid = __builtin_amdgcn_readfirstlane((int)threadIdx.x >> 6);
#define lane0 lane_now()
#define tid0 (wid * 64 + lane_now())
    int G = gridDim.x, bid = blockIdx.x;
    int gw = bid * 8 + wid, NGW = G * 8;
    unsigned char* ws = args.ws;
    float* out = args.out;
    const float* modl = nullptr;
    float* modv = (float*)(ws + WS_MOD);
    float* cosM = (float*)(ws + WS_COSM); float* sinM = (float*)(ws + WS_SINM);
    float* cosG = (float*)(ws + WS_COSG); float* sinG = (float*)(ws + WS_SING);
    bf16_t* HO = (bf16_t*)(ws + WS_HO);
    bf16_t* P = (bf16_t*)(ws + WS_P);
    bf16_t* QM = (bf16_t*)(ws + WS_QM);
    bf16_t* KV = (bf16_t*)(ws + WS_KV);
    bf16_t* KR = (bf16_t*)(ws + WS_KR);
    bf16_t* HF = (bf16_t*)(ws + WS_HF);
    bf16_t* P2 = (bf16_t*)(ws + WS_P2);
    bf16_t* KG = (bf16_t*)(ws + WS_KG);
    bf16_t* VG = (bf16_t*)(ws + WS_VG);
    const float* x_prompt = args.in[0]; const float* x_sample = args.in[1];
    int t00 = tid0; asm volatile("" : "+v"(t00));
    if (t00 == 0) {
        LAS unsigned long long* pp = (LAS unsigned long long*)(lds + LDS_PTRS);
#pragma unroll
        for (int k = 0; k < 28; ++k) pp[k] = (unsigned long long)args.in[k];
        pp[28] = (unsigned long long)args.out; pp[29] = (unsigned long long)args.ws;
    }

    if (args.ws == nullptr) grid.sync();
    if (tid0 < 2) *(volatile LAS unsigned*)(lds + 131072 + 512 + 4 * tid0) = 0u;
    __syncthreads();
    const XcdBarrier xbar = xcd_barrier_post((unsigned*)(ws + WS_BAR), (volatile LAS unsigned*)(lds + 131072 + 512), wid);
    {
        int tid = tid0; asm volatile("" : "+v"(tid)); const int lane = tid & 63;
        int tb = 0;
        tjob(args.in[15], 1024, 2080, (bf16_t*)(ws + WS_WINA), 1, tb, lds, gw, NGW, wid, lane);
        tjob(args.in[17], 256, 768, (bf16_t*)(ws + WS_WUQ), 0, tb, lds, gw, NGW, wid, lane);
        tjob(args.in[19], 256, 1024, (bf16_t*)(ws + WS_WUKV), 0, tb, lds, gw, NGW, wid, lane);
        tjob(args.in[21], 1024, 1024, (bf16_t*)(ws + WS_WOUTA), 0, tb, lds, gw, NGW, wid, lane);
        tjob(args.in[26], 1024, 2 * DFF, (bf16_t*)(ws + WS_WF1_0), 2, tb, lds, gw, NGW, wid, lane);
        tjob(args.in[27], DFF, 1024, (bf16_t*)(ws + WS_WF2_0), 0, tb, lds, gw, NGW, wid, lane);
        { u32x4* z = (u32x4*)((bf16_t*)(ws + WS_WINA) + (size_t)2080 * 1024); const int n16 = 224 * 1024 * 2 / 16;
          for (int i = bid * 512 + tid; i < n16; i += G * 512) z[i] = (u32x4){0u, 0u, 0u, 0u}; }
        for (int i = bid * 512 + tid; i < 4096 * 80; i += G * 512) {
            int t, j, pos; float ex;
            if (i < 4096 * 16) { t = i >> 4; j = i & 15; pos = (j < 8) ? (t >> 6) : (t & 63); ex = (float)(2 * (j & 7)) * (1.0f / 16.0f); }
            else { const int i2 = i - 4096 * 16; t = i2 >> 6; j = i2 & 63; pos = (j < 32) ? (t >> 6) : (t & 63); ex = (float)(2 * (j & 31)) * (1.0f / 64.0f); }
            const float x = exp2f(-ex * 13.287712379549449f), x2 = x * x;
            float cb = 1.0f + x2 * (-0.5f + x2 * (4.1666666666666664e-2f + x2 * (-1.3888888888888889e-3f + x2 * (2.4801587301587302e-5f + x2 * (-2.7557319223985888e-7f)))));
            float sb = x * (1.0f + x2 * (-1.6666666666666666e-1f + x2 * (8.3333333333333332e-3f + x2 * (-1.9841269841269841e-4f + x2 * (2.7557319223985893e-6f + x2 * (-2.5052108385441720e-8f))))));
            float rc = 1.0f, rs = 0.0f;
#pragma unroll
            for (int bb = 0; bb < 6; ++bb) {
                if (pos & (1 << bb)) { const float tt = rc * cb - rs * sb; rs = rc * sb + rs * cb; rc = tt; }
                const float t2 = cb * cb - sb * sb; sb = 2.0f * cb * sb; cb = t2;
            }
            if (i < 4096 * 16) { cosM[i] = rc; sinM[i] = rs; } else { cosG[i - 4096 * 16] = rc; sinG[i - 4096 * 16] = rs; }
        }
        for (int j = gw; j < 1024; j += NGW) {
            const size_t row = MTOK + j;
            { const f32x4 v = *(const f32x4*)(args.in[2] + (size_t)j * 256 + 4 * lane); u32x2 w; w.x = cvtpk(v[0], v[1]); w.y = cvtpk(v[2], v[3]); *(u32x2*)(P + row * LDP + 256 + 4 * lane) = w; }
#pragma unroll
            for (int q = 0; q < 2; ++q) {
                const f32x4 v = *(const f32x4*)(args.in[4] + (size_t)j * 512 + 256 * q + 4 * lane); u32x2 w; w.x = cvtpk(v[0], v[1]); w.y = cvtpk(v[2], v[3]); *(u32x2*)(P + row * LDP + 1024 + 256 * q + 4 * lane) = w;
                const f32x4 u = *(const f32x4*)(args.in[5] + (size_t)j * 512 + 256 * q + 4 * lane); u32x2 w2; w2.x = cvtpk(u[0], u[1]); w2.y = cvtpk(u[2], u[3]); *(u32x2*)(P + row * LDP + 1536 + 256 * q + 4 * lane) = w2;
            }
            if (lane < 16) { const float v0 = args.in[3][(size_t)j * 32 + 2 * lane], v1 = args.in[3][(size_t)j * 32 + 2 * lane + 1]; *(unsigned*)(KR + row * 32 + 2 * lane) = cvtpk(v0, v1); }
        }
        __syncthreads();
        if (bid < 192) {
            const int l = bid / 96, col0 = (bid % 96) * 64;
            LAS float* scond = (LAS float*)lds;
            LAS float* red = (LAS float*)(lds + 20480);
            for (int i = tid; i < 5 * 1024; i += 512) { const int gI = i >> 10, k = i & 1023; const float x = (gI < 4) ? args.in[8][gI * 1024 + k] : args.in[9][k]; scond[i] = x / (1.0f + expf(-x)); }
            __syncthreads();
            const int cq = tid & 15, kl = tid >> 4;
            f32x4 acc[5];
#pragma unroll
            for (int gI = 0; gI < 5; ++gI) acc[gI] = (f32x4){0.f, 0.f, 0.f, 0.f};
            const float* wp = args.in[10] + (size_t)l * 1024 * 6144 + col0 + 4 * cq;
#pragma unroll 2
            for (int k = kl; k < 1024; k += 32) {
                const f32x4 w = *(const f32x4*)(wp + (size_t)k * 6144);
#pragma unroll
                for (int gI = 0; gI < 5; ++gI) acc[gI] += w * scond[gI * 1024 + k];
            }
#pragma unroll
            for (int gI = 0; gI < 5; ++gI) *(LAS f32x4*)(red + (kl * 5 + gI) * 64 + 4 * cq) = acc[gI];
            __syncthreads();
            if (tid < 320) { const int gI = tid >> 6, c = tid & 63; float s = args.in[11][l * 6144 + col0 + c];
                for (int k2 = 0; k2 < 32; ++k2) s += red[(k2 * 5 + gI) * 64 + c];
                modv[(l * 5 + gI) * 6144 + col0 + c] = s; }
            __syncthreads();
        }
    }
    xcd_barrier(xbar); PH_RELOAD;

#pragma unroll
    for (int l = 0; l < 2; ++l) {
        PH_RELOAD; modl = modv + l * 5 * 6144;
        if (l == 0) norm_mod_rows(x_prompt, x_sample, AIN(12), modl, 0, 1, HO, gw, NGW, lane0);
        else norm_mod_rows(out, out + (size_t)MCTX * D, AIN(12) + 1024, modl, 0, 1, HO, gw, NGW, lane0, (G == 256) ? (const bf16_t*)(ws + WS_PART) : nullptr, out);
        xcd_barrier(xbar); PH_RELOAD; modl = modv + l * 5 * 6144;

        if (l == 0) {
            {
                pg8::Gemm g{HO, (const bf16_t*)(ws + WS_WINA), MTOK, NINA, 1024, 1024, 1024};
                pg8::StaticOrder S; S.init(MTOK, NINA, G, bid, 1024);
                pg8::EpiInA E{P, out + O_NAK, out + O_NAV, out + O_KROPE};
                if (DBG_GM & 1) pg8::gemm_phase<pg8::EpiInA, true>(lds, g, S, E, wid);
            }
            xcd_barrier(xbar); PH_RELOAD; modl = modv + l * 5 * 6144;
            int lane = lane0; asm volatile("" : "+v"(lane));
            for (int row = gw; row < MTOK; row += NGW) {
                bf16_t* pr = P + (size_t)row * LDP;
                const u32x2 a = *(const u32x2*)(pr + 4 * lane), b = *(const u32x2*)(pr + 256 + 4 * lane);
                float x[4] = {bf_lo(a.x), bf_hi(a.x), bf_lo(a.y), bf_hi(a.y)}, y[4] = {bf_lo(b.x), bf_hi(b.x), bf_lo(b.y), bf_hi(b.y)};
                const float sx = wave_sum(x[0] * x[0] + x[1] * x[1] + x[2] * x[2] + x[3] * x[3], lane);
                const float sy = wave_sum(y[0] * y[0] + y[1] * y[1] + y[2] * y[2] + y[3] * y[3], lane);
                const float rx = 1.0f / sqrtf(sx * (1.0f / 256.0f) + RMS_EPS), ry = 1.0f / sqrtf(sy * (1.0f / 256.0f) + RMS_EPS);
                const f32x4 gq = *(const f32x4*)(AIN(16) + 4 * lane), gk = *(const f32x4*)(AIN(18) + 4 * lane);
                f32x4 xn, yn;
#pragma unroll
                for (int e = 0; e < 4; ++e) { xn[e] = x[e] * rx * gq[e]; yn[e] = y[e] * ry * gk[e]; }
                u32x2 w; w.x = cvtpk(xn[0], xn[1]); w.y = cvtpk(xn[2], xn[3]); *(u32x2*)(pr + 4 * lane) = w;
                w.x = cvtpk(yn[0], yn[1]); w.y = cvtpk(yn[2], yn[3]); *(u32x2*)(pr + 256 + 4 * lane) = w;
                if (row < MCTX) *(f32x4*)(out + O_CKV + (size_t)row * 256 + 4 * lane) = yn;
                if (lane < 16) {
                    float x1 = __uint_as_float((unsigned)pr[2048 + lane] << 16), x2 = __uint_as_float((unsigned)pr[2064 + lane] << 16);
                    if (row >= MCTX) { const int t = (row - MCTX) & 4095; const float c = cosM[t * 16 + lane], s = sinM[t * 16 + lane];
                        const float n1 = x1 * c - x2 * s, n2 = x1 * s + x2 * c; x1 = n1; x2 = n2; }
                    KR[(size_t)row * 32 + lane] = (bf16_t)(cvtpk(x1, 0.f) & 0xffffu); KR[(size_t)row * 32 + 16 + lane] = (bf16_t)(cvtpk(x2, 0.f) & 0xffffu);
                }
            }
            xcd_barrier(xbar); PH_RELOAD; modl = modv + l * 5 * 6144;
            {
                pg8::Gemm g{P, (const bf16_t*)(ws + WS_WUQ), MTOK, 768, 256, LDP, 256};
                pg8::StaticOrder S; S.init(g.M, g.N, G, bid, 256);
                pg8::EpiStore E{QM, 768};
                if (DBG_GM & 2) pg8::gemm_phase<pg8::EpiStore, true>(lds, g, S, E, wid);
            }
            {
                pg8::Gemm g{P + 256, (const bf16_t*)(ws + WS_WUKV), MALL, 1024, 256, LDP, 256};
                pg8::StaticOrder S; S.init(g.M, g.N, G, bid, 256);
                pg8::EpiStore E{KV, 1024};
                if (DBG_GM & 2) pg8::gemm_phase<pg8::EpiStore, true>(lds, g, S, E, wid);
            }
            xcd_barrier(xbar); PH_RELOAD; modl = modv + l * 5 * 6144;
            {
                bf16_t* O = HO;
                const float mla_sc = 0.10206207261596575f * LOG2E, na_sc = 0.125f * LOG2E;
                int bidl = bid; asm volatile("" : "+s"(bidl));
                const bool xmap = (G == 256); const int xcd = bidl & 7, jb = bidl >> 3;
                for (int u = bidl; u < 1280; u += G) {
                    AttnArgs a{};
                    a.O = nullptr;
                    if (u < 512) {
                        const int v = jb + 32 * (u >> 8), b = xmap ? (xcd >> 1) : (u >> 7), h = xmap ? ((xcd & 1) * 4 + (v >> 4)) : ((u >> 4) & 7), qb = xmap ? (v & 15) : (u & 15);
                        a.Q = QM + h * 96; a.ldq = 768; a.Ka = KV + h * 128; a.ldka = 1024; a.Kb = KR; a.ldkb = 32; a.V = KV + h * 128 + 64; a.ldv = 1024;
                        a.O = O + h * 64; a.ldo = 1024; a.qrow0 = MCTX + b * 4096 + qb * 256; a.seg0row = MCTX + b * 4096; a.seg0n = 4096; a.seg1row = MTOK + b * 256; a.seg1n = 256;
                        a.scale_log2 = mla_sc; a.rope = 1; a.tpos0 = qb * 256; a.cosT = cosM; a.sinT = sinM;
                        attn_unit<96, 64, 8, 1, false>(lds, a, wid);
                    } else if (u < 1024) {
                        const int w = u - 512, v = jb + 32 * (w >> 8), b = xmap ? (xcd >> 1) : (w >> 7), h = xmap ? ((xcd & 1) * 4 + (v >> 4)) : ((w >> 4) & 7), qb = xmap ? (v & 15) : (w & 15), r0 = 4 * qb;
                        const int rsmin = min(max(r0 - 4, 0), 56), rsmax = min(max(r0 + 3 - 4, 0), 56), nb = rsmax + 8 - rsmin;
                        a.Q = P + 512 + h * 64; a.ldq = LDP; a.Ka = P + 1024 + h * 64; a.ldka = LDP; a.Kb = a.Ka; a.ldkb = LDP; a.V = P + 1536 + h * 64; a.ldv = LDP;
                        a.O = O + 512 + h * 64; a.ldo = 1024; a.qrow0 = MCTX + b * 4096 + qb * 256; a.seg0row = MTOK + b * 256; a.seg0n = 256; a.seg1row = MCTX + b * 4096 + rsmin * 64; a.seg1n = nb * 64;
                        a.scale_log2 = na_sc; a.rpb = AIN(20) + h * 465; a.r0 = r0; a.rsmin = rsmin;
                        attn_unit<64, 64, 8, 0, true>(lds, a, wid);
                    } else if (u < 1152) {
                        const int v = u - 1024, b = v >> 3, h = v & 7;
                        a.Q = QM + h * 96; a.ldq = 768; a.Ka = KV + h * 128; a.ldka = 1024; a.Kb = KR; a.ldkb = 32; a.V = KV + h * 128 + 64; a.ldv = 1024;
                        a.O = O + h * 64; a.ldo = 1024; a.qrow0 = b * 256; a.seg0row = b * 256; a.seg0n = 256; a.seg1row = 0; a.seg1n = 0;
                        a.scale_log2 = mla_sc; a.rope = 0; a.tpos0 = 0; a.cosT = cosM; a.sinT = sinM;
                        attn_unit<96, 64, 8, 1, false>(lds, a, wid);
                    } else {
                        const int v = u - 1152, b = v >> 3, h = v & 7;
                        a.Q = P + 512 + h * 64; a.ldq = LDP; a.Ka = P + 1024 + h * 64; a.ldka = LDP; a.Kb = a.Ka; a.ldkb = LDP; a.V = P + 1536 + h * 64; a.ldv = LDP;
                        a.O = O + 512 + h * 64; a.ldo = 1024; a.qrow0 = b * 256; a.seg0row = b * 256; a.seg0n = 256; a.seg1row = 0; a.seg1n = 0;
                        a.scale_log2 = na_sc;
                        attn_unit<64, 64, 8, 0, false>(lds, a, wid);
                    }
                }
            }
            xcd_barrier(xbar); PH_RELOAD; modl = modv + l * 5 * 6144;
        } else {
            {
                pg8::Gemm g{HO, (const bf16_t*)(ws + WS_WINC), MTOK, NINC, 1024, 1024, 1024};
                pg8::StaticOrder S; S.init(MTOK, NINC, G, bid, 1024);
                pg8::EpiInC E{P2, out + O_GV};
                if (DBG_GM & 4) pg8::gemm_phase<pg8::EpiInC, true>(lds, g, S, E, wid);
            }
            xcd_barrier(xbar); PH_RELOAD; modl = modv + l * 5 * 6144;
            int lane = lane0; asm volatile("" : "+v"(lane));
            for (int row = gw; row < MALL; row += NGW) {
                if (row < MTOK) {
                    const bf16_t* pr = P2 + (size_t)row * NINC;
#pragma unroll
                    for (int kvh = 0; kvh < 2; ++kvh) {
                        const float x1 = __uint_as_float((unsigned)pr[1024 + kvh * 128 + lane] << 16), x2 = __uint_as_float((unsigned)pr[1024 + kvh * 128 + 64 + lane] << 16);
                        const float ss = wave_sum(x1 * x1 + x2 * x2, lane);
                        const float rstd = 1.0f / sqrtf(ss * (1.0f / 128.0f) + RMS_EPS);
                        float k1 = x1 * rstd * AIN(24)[lane], k2 = x2 * rstd * AIN(24)[64 + lane];
                        if (row < MCTX) { out[O_GK + (size_t)row * 256 + kvh * 128 + lane] = k1; out[O_GK + (size_t)row * 256 + kvh * 128 + 64 + lane] = k2; }
                        else { const int t = (row - MCTX) & 4095; const float c = cosG[t * 64 + lane], s = sinG[t * 64 + lane];
                            const float n1 = k1 * c - k2 * s, n2 = k1 * s + k2 * c; k1 = n1; k2 = n2; }
                        KG[(size_t)row * 256 + kvh * 128 + lane] = (bf16_t)(cvtpk(k1, 0.f) & 0xffffu); KG[(size_t)row * 256 + kvh * 128 + 64 + lane] = (bf16_t)(cvtpk(k2, 0.f) & 0xffffu);
                    }
                    *(u32x2*)(VG + (size_t)row * 256 + 4 * lane) = *(const u32x2*)(pr + 1280 + 4 * lane);
                } else {
                    const int j = row - MTOK;
                    const f32x4 kk = *(const f32x4*)(AIN(6) + (size_t)j * 256 + 4 * lane), vv = *(const f32x4*)(AIN(7) + (size_t)j * 256 + 4 * lane);
                    u32x2 w; w.x = cvtpk(kk[0], kk[1]); w.y = cvtpk(kk[2], kk[3]); *(u32x2*)(KG + (size_t)row * 256 + 4 * lane) = w;
                    w.x = cvtpk(vv[0], vv[1]); w.y = cvtpk(vv[2], vv[3]); *(u32x2*)(VG + (size_t)row * 256 + 4 * lane) = w;
                }
            }
            xcd_barrier(xbar); PH_RELOAD; modl = modv + l * 5 * 6144;
            {
                bf16_t* O = HO;
                const float sc = 0.08838834764831845f * LOG2E;
                int bidl = bid; asm volatile("" : "+s"(bidl));
                const bool xmap = (G == 256);
                for (int u = bidl; u < 640; u += G) {
                    AttnArgs a{};
                    int h;
                    if (u < 512) { const int v = (bidl >> 3) + 32 * (u >> 8), b = xmap ? ((bidl & 7) >> 1) : (u >> 7), qb = xmap ? (v & 15) : (u & 15); h = xmap ? ((bidl & 1) * 4 + (v >> 4)) : ((u >> 4) & 7);
                        a.qrow0 = MCTX + b * 4096 + qb * 256; a.seg0row = MCTX + b * 4096; a.seg0n = 4096; a.seg1row = MTOK + b * 256; a.seg1n = 256; a.rope = 1; a.tpos0 = qb * 256;
                    } else { const int v = u - 512, b = v >> 3; h = v & 7;
                        a.qrow0 = b * 256; a.seg0row = b * 256; a.seg0n = 256; a.seg1row = 0; a.seg1n = 0; a.rope = 0; a.tpos0 = 0; }
                    a.Q = P2 + h * 128; a.ldq = NINC; a.Ka = KG + (h >> 2) * 128; a.ldka = 256; a.Kb = a.Ka; a.ldkb = 256; a.V = VG + (h >> 2) * 128; a.ldv = 256;
                    a.O = O + h * 128; a.ldo = 1024; a.scale_log2 = sc; a.cosT = cosG; a.sinT = sinG; a.qnorm = AIN(23);
                    attn_unit<128, 128, 16, 2, false>(lds, a, wid);
                }
            }
            xcd_barrier(xbar); PH_RELOAD; modl = modv + l * 5 * 6144;
        }
        {
            pg8::Gemm g{HO, (const bf16_t*)(ws + (l == 0 ? WS_WOUTA : WS_WOUTC)), MTOK, 1024, 1024, 1024, 1024};
            pg8::StaticOrder S; S.init(MTOK, 1024, G, bid, 1024, (G == 256) ? 1 : 0);
            pg8::EpiRes E{l == 0 ? x_prompt : out, l == 0 ? x_sample : out + (size_t)MCTX * D, out, modl + 2 * 1024, (bf16_t*)(ws + WS_PART)};
            if (DBG_GM & 8) pg8::gemm_phase<pg8::EpiRes, true>(lds, g, S, E, wid);
        }
        xcd_barrier(xbar); PH_RELOAD; modl = modv + l * 5 * 6144;
        norm_mod_rows(out, out + (size_t)MCTX * D, AIN(13) + l * 1024, modl, 3, 4, HO, gw, NGW, lane0, (G == 256) ? (const bf16_t*)(ws + WS_PART) : nullptr, out, (l == 0 && G == 256) ? x_sample + (size_t)(16384 - MCTX) * D : nullptr);
        if (l == 0) {
            int tb = 0;
            tjob(AIN(22), 1024, NINC, (bf16_t*)(ws + WS_WINC), 0, tb, lds, gw, NGW, wid, lane0);
            tjob(AIN(25), 1024, 1024, (bf16_t*)(ws + WS_WOUTC), 0, tb, lds, gw, NGW, wid, lane0);
            tjob(AIN(26) + (size_t)1024 * 2 * DFF, 1024, 2 * DFF, (bf16_t*)(ws + WS_WF1_1), 2, tb, lds, gw, NGW, wid, lane0);
            tjob(AIN(27) + (size_t)DFF * 1024, DFF, 1024, (bf16_t*)(ws + WS_WF2_1), 0, tb, lds, gw, NGW, wid, lane0);
        }
        xcd_barrier(xbar); PH_RELOAD; modl = modv + l * 5 * 6144;
        {
            pg8::Gemm g{HO, (const bf16_t*)(ws + (l == 0 ? WS_WF1_0 : WS_WF1_1)), MTOK, 2 * DFF, 1024, 1024, 1024};
            pg8::StaticOrder S; S.init(MTOK, 2 * DFF, G, bid, 1024);
            pg8::EpiSwiglu E{HF};
            if (DBG_GM & 16) pg8::gemm_phase<pg8::EpiSwiglu, true>(lds, g, S, E, wid);
        }
        xcd_barrier(xbar); PH_RELOAD; modl = modv + l * 5 * 6144;
        {
            pg8::Gemm g{HF, (const bf16_t*)(ws + (l == 0 ? WS_WF2_0 : WS_WF2_1)), MTOK, 1024, DFF, DFF, DFF};
            pg8::StaticOrder S; S.init(MTOK, 1024, G, bid, DFF, (G == 256) ? 1 : 0);
            pg8::EpiRes E{out, out + (size_t)MCTX * D, out, modl + 5 * 1024, (bf16_t*)(ws + WS_PART)};
            if (DBG_GM & 32) pg8::gemm_phase<pg8::EpiRes, true>(lds, g, S, E, wid);
        }
        xcd_barrier(xbar); PH_RELOAD; modl = modv + l * 5 * 6144;
    }
    PH_RELOAD;
    int lane = lane0; asm volatile("" : "+v"(lane));
    for (int row = gw; row < MTOK; row += NGW) {
        float* xr = out + (size_t)row * D;
        f32x4 v[4]; float s = 0.f;
#pragma unroll
        for (int j = 0; j < 4; ++j) v[j] = *(const f32x4*)(xr + 4 * lane + 256 * j);
        if (G == 256 && row >= 16384) {
            const bf16_t* part = (const bf16_t*)(ws + WS_PART);
#pragma unroll
            for (int p = 0; p < 4; ++p)
#pragma unroll
                for (int j = 0; j < 4; ++j) { const u32x2 w = *(const u32x2*)(part + ((size_t)p * 4096 + (row - 16384)) * 1024 + 4 * lane + 256 * j);
                    v[j][0] += bf_lo(w.x); v[j][1] += bf_hi(w.x); v[j][2] += bf_lo(w.y); v[j][3] += bf_hi(w.y); }
        }
#pragma unroll
        for (int j = 0; j < 4; ++j) s += v[j][0] * v[j][0] + v[j][1] * v[j][1] + v[j][2] * v[j][2] + v[j][3] * v[j][3];
        const float rstd = 1.0f / sqrtf(wave_sum(s, lane) * (1.0f / D) + RMS_EPS);
#pragma unroll
        for (int j = 0; j < 4; ++j) { const f32x4 gg = *(const f32x4*)(AIN(14) + 4 * lane + 256 * j); *(f32x4*)(xr + 4 * lane + 256 * j) = v[j] * rstd * gg; }
    }
}

extern "C" void kernel_launch(void* const* d_in, const int* in_sizes, int n_in, void* d_out, int out_size, void* d_ws, size_t ws_size, hipStream_t stream) {
    static int grid_blocks = 0;
    if (grid_blocks == 0) {
        if (n_in != 28 || ws_size < WS_END0) { fprintf(stderr, "kernel_launch: unexpected n_in %d / ws_size %zu\n", n_in, ws_size); grid_blocks = -1; return; }
        int dev = 0, cus = 0, per_cu = 0;
        hipGetDevice(&dev);
        hipDeviceGetAttribute(&cus, hipDeviceAttributeMultiprocessorCount, dev);
        hipFuncSetAttribute((const void*)fwd_kernel, hipFuncAttributeMaxDynamicSharedMemorySize, LDS_BYTES);
        hipOccupancyMaxActiveBlocksPerMultiprocessor(&per_cu, (const void*)fwd_kernel, 512, LDS_BYTES);
        (void)hipGetLastError();
        if (per_cu < 1) per_cu = 1;
        grid_blocks = cus * 1;
        if (grid_blocks > 256) grid_blocks = 256;
    }
    if (grid_blocks < 0) return;
    if (hipMemsetAsync((char*)d_ws + WS_BAR, 0, XCD_BAR_WORDS * 4, stream) != hipSuccess) { fprintf(stderr, "kernel_launch: memset of barrier words failed\n"); return; }
    KArgs a{};
    for (int i = 0; i < 28; ++i) a.in[i] = (const float*)d_in[i];
    a.out = (float*)d_out; a.ws = (unsigned char*)d_ws;
    void* kargs[] = {&a};
    hipError_t e = hipLaunchCooperativeKernel((const void*)fwd_kernel, dim3(grid_blocks), dim3(512), kargs, LDS_BYTES, stream);
    if (e != hipSuccess) fprintf(stderr, "cooperative launch failed: %s (grid %d)\n", hipGetErrorString(e), grid_blocks);
}
```

```cpp
#include <hip/hip_runtime.h>
#include <hip/hip_cooperative_groups.h>
#include <cstdint>
#include <cstdio>
namespace cg = cooperative_groups;

#define LAS __attribute__((address_space(3)))
typedef unsigned short bf16_t;
typedef short bf16x8 __attribute__((ext_vector_type(8)));
typedef short s16x4 __attribute__((ext_vector_type(4)));
typedef float f32x4 __attribute__((ext_vector_type(4)));
typedef float f32x16 __attribute__((ext_vector_type(16)));
typedef unsigned u32x4 __attribute__((ext_vector_type(4)));
typedef unsigned u32x2 __attribute__((ext_vector_type(2)));
typedef float f32x2_t __attribute__((ext_vector_type(2)));
typedef __bf16 bf16x2_t __attribute__((ext_vector_type(2)));

__device__ __forceinline__ unsigned cvtpk(float lo, float hi) { f32x2_t v = {lo, hi}; bf16x2_t b = __builtin_convertvector(v, bf16x2_t); return __builtin_bit_cast(unsigned, b); }
__device__ __forceinline__ float bf_lo(unsigned u) { return __uint_as_float(u << 16); }
__device__ __forceinline__ float bf_hi(unsigned u) { return __uint_as_float(u & 0xffff0000u); }
__device__ __forceinline__ int lane_now() { int r; asm volatile("v_mbcnt_lo_u32_b32 %0, -1, 0\n\tv_mbcnt_hi_u32_b32 %0, -1, %0" : "=v"(r)); return r; }
__device__ __forceinline__ float wave_sum(float v, int lane) {
#pragma unroll
    for (int o = 32; o >= 1; o >>= 1) v += __builtin_bit_cast(float, __builtin_amdgcn_ds_bpermute((lane ^ o) << 2, __builtin_bit_cast(int, v)));
    return v;
}
__device__ __forceinline__ float half_sum(float v) { auto r = __builtin_amdgcn_permlane32_swap(__float_as_uint(v), __float_as_uint(v), false, false); return __uint_as_float(r[0]) + __uint_as_float(r[1]); }
__device__ __forceinline__ float half_max(float v) { auto r = __builtin_amdgcn_permlane32_swap(__float_as_uint(v), __float_as_uint(v), false, false); return fmaxf(__uint_as_float(r[0]), __uint_as_float(r[1])); }

constexpr int D = 1024, MCTX = 4096, MLAT = 16384, MTOK = 20480, MALL = 21504;
constexpr int DFF = 2816, NINA = 2304, LDP = 2304, NINC = 1536;
constexpr float RMS_EPS = 1e-6f;
constexpr float LOG2E = 1.4426950408889634f;
constexpr size_t MiB = 1u << 20;
constexpr size_t WS_MOD = 0;
constexpr size_t WS_BAR = 512 * 1024;
constexpr size_t WS_COSM = 1 * MiB, WS_SINM = 1 * MiB + 262144, WS_COSG = 2 * MiB, WS_SING = 3 * MiB;
constexpr size_t WS_WINA = 4 * MiB;
constexpr size_t WS_WUQ = WS_WINA + 4718592;
constexpr size_t WS_WUKV = WS_WUQ + 393216;
constexpr size_t WS_WOUTA = WS_WUKV + 524288;
constexpr size_t WS_WF1_0 = WS_WOUTA + 2097152;
constexpr size_t WS_WF2_0 = WS_WF1_0 + 11534336;
constexpr size_t WS_HO = 28 * MiB;
constexpr size_t WS_BIG = 68 * MiB;
constexpr size_t WS_P = WS_BIG;
constexpr size_t WS_QM = WS_P + 99090432;
constexpr size_t WS_KV = WS_QM + 31457280;
constexpr size_t WS_KR = WS_KV + 44040192;
constexpr size_t WS_END0 = WS_KR + 1376256;
constexpr size_t WS_HF = WS_BIG;
constexpr size_t WS_W1 = WS_BIG + 112 * MiB;
constexpr size_t WS_WINC = WS_W1;
constexpr size_t WS_WOUTC = WS_WINC + 3145728;
constexpr size_t WS_WF1_1 = WS_WOUTC + 2097152;
constexpr size_t WS_WF2_1 = WS_WF1_1 + 11534336;
constexpr size_t WS_PART = WS_BIG + 134 * MiB;
constexpr size_t WS_P2 = WS_BIG;
constexpr size_t WS_KG = WS_BIG + 60 * MiB;
constexpr size_t WS_VG = WS_KG + 11010048;
static_assert(WS_WF2_0 + 5767168 <= WS_HO, "w0");
static_assert(WS_END0 <= 256 * MiB, "ws");
static_assert(WS_WF2_1 + 5767168 <= WS_PART && WS_PART + 33554432 <= WS_END0, "w1/part");
constexpr size_t O_Y = 0, O_CKV = 20971520, O_KROPE = 22020096, O_NAK = 22151168, O_NAV = 24248320, O_GK = 26345472, O_GV = 27394048;

constexpr int LDS_BYTES = 147456;
#ifndef DBG_GM
#define DBG_GM 0xff
#endif

namespace pg8 {
constexpr int BM = 256, BK = 64, HALF = 128, HTB = HALF * BK * 2, STAGE_BYTES = 8 * HTB, NXCD = 8, WGM = 8;
__host__ __device__ __forceinline__ int lds_byte(int r, int c) { const int st = (r >> 4) * 2 + (c >> 5), rr = r & 15, cc = c & 31, ob = rr * 64 + cc * 2; return st * 1024 + (ob ^ (((ob >> 9) & 1) << 5)); }
__host__ __device__ __forceinline__ void stage_rc(int b, int& R, int& C) { const int st = b / 1024, sb = b % 1024, swz = sb ^ (((sb >> 9) & 1) << 5); R = (st >> 1) * 16 + swz / 64; C = (st & 1) * 32 + (swz % 64) / 2; }
__host__ __device__ __forceinline__ int perm32(int rho) { const int n = rho >> 4, i = rho & 15; return 8 * (i >> 2) + 4 * n + (i & 3); }
struct Unit { int pm, pn, k0, nt, part; };
struct Gemm { const bf16_t* A; const bf16_t* Bt; int M, N, K, lda, ldb; };
struct StaticOrder {
    int nM, nN, nwg, G, c, K, hybrid;
    __device__ void init(int M, int N, int G_, int c_, int K_ = 0, int hybrid_ = 0) { nM = hybrid_ ? 64 : M / BM; nN = N / BM; nwg = nM * nN; G = G_; c = c_; K = K_; hybrid = hybrid_; }
    __device__ bool next(int i, Unit& u) const {
        long L = (long)i * G + c; u.k0 = 0; u.nt = K / BK; u.part = 0;
        if (hybrid) {
            if (i > 1) return false;
            const int role = ((c >> 3) & 1) ? (1 - i) : i;
            if (role == 0) L = c;
            if (role == 1) { const int p = c >> 6; u.part = 1 + p; u.pm = 64 + ((c & 63) >> 2); u.pn = c & 3;
                if (K == 1024) { u.nt = 4; u.k0 = 256 * p; } else { u.nt = (p < 2) ? 12 : 10; u.k0 = (p < 2) ? 768 * p : 1536 + 640 * (p - 2); }
                return true; }
        }
        if (L >= nwg) return false;
        int wgid = (int)L; { const int q = nwg / NXCD, r = nwg % NXCD, xcd = wgid % NXCD, off = wgid / NXCD; wgid = (xcd < r ? xcd * (q + 1) : r * (q + 1) + (xcd - r) * q) + off; }
        const int nig = WGM * nN, gid = wgid / nig, fm = gid * WGM, gsz = (nM - fm) < WGM ? (nM - fm) : WGM;
        u.pm = fm + ((wgid % nig) % gsz); u.pn = (wgid % nig) / gsz; return true;
    }
};
template <class Epi, bool ALIGN_EPI>
__device__ __forceinline__ void gemm_phase(LAS unsigned char* lds, const Gemm g, const StaticOrder& S, const Epi& E, const int wid_in) {
    int tid_ = wid_in * 64 + lane_now(); asm volatile("" : "+v"(tid_));
    const int tid = tid_, wid = __builtin_amdgcn_readfirstlane(tid >> 6), lane = tid & 63, wr = wid >> 2, wc = wid & 3, fr = lane & 15, fq = lane >> 4;
    unsigned voffA[2], voffB[2];
#pragma unroll
    for (int i = 0; i < 2; ++i) { int R, C; stage_rc(tid * 16 + i * 8192, R, C); const int Rb = (R & ~31) + perm32(R & 31);
        voffA[i] = (unsigned)(R * g.lda + C) * 2u; voffB[i] = (unsigned)(Rb * g.ldb + C) * 2u; }
    const size_t kstep = (size_t)(BK * 2);
    const size_t hA = (size_t)HALF * g.lda * 2, hB = (size_t)HALF * g.ldb * 2, tA = 2 * hA, tB = 2 * hB;
    const unsigned ldsw = (unsigned)wid * 1024u;
    const int aoff = lds_byte(wr * 64 + fr, fq * 8), boff = lds_byte(wc * 32 + fr, fq * 8);
#define PG8_SA(b, h) (((b) * 2 + (h)) * HTB)
#define PG8_SB(b, h) ((4 + (b) * 2 + (h)) * HTB)
#define PG8_STAGE(bufoff, gbase, voff) do { _Pragma("unroll") for (int _i = 0; _i < 2; ++_i) \
        __builtin_amdgcn_global_load_lds((const unsigned*)((const char*)(gbase) + (voff)[_i]), (LAS unsigned*)(lds + (bufoff) + ldsw + _i * 8192), 16, 0, 0); } while (0)
#define PG8_LDA(dst, b, h) do { _Pragma("unroll") for (int m = 0; m < 4; ++m) _Pragma("unroll") for (int k = 0; k < 2; ++k) dst[m][k] = *(const LAS bf16x8*)(lds + PG8_SA(b, h) + aoff + m * 2048 + k * 1024); } while (0)
#define PG8_LDB(dst, b, h) do { _Pragma("unroll") for (int n = 0; n < 2; ++n) _Pragma("unroll") for (int k = 0; k < 2; ++k) dst[n][k] = *(const LAS bf16x8*)(lds + PG8_SB(b, h) + boff + n * 2048 + k * 1024); } while (0)
#define PG8_MMA(ai, bj, At, Bt) do { __builtin_amdgcn_s_setprio(1); _Pragma("unroll") for (int m = 0; m < 4; ++m) _Pragma("unroll") for (int n = 0; n < 2; ++n) _Pragma("unroll") for (int k = 0; k < 2; ++k) \
        acc[ai][bj][m][n] = __builtin_amdgcn_mfma_f32_16x16x32_bf16(Bt[n][k], At[m][k], acc[ai][bj][m][n], 0, 0, 0); __builtin_amdgcn_s_setprio(0); } while (0)
#define PG8_WAIT_V(n) asm volatile("s_waitcnt vmcnt(" #n ")" ::: "memory")
#define PG8_WAIT_L(n) asm volatile("s_waitcnt lgkmcnt(" #n ")" ::: "memory")
#define PG8_BAR __builtin_amdgcn_s_barrier()
#define PG8_SCHED __builtin_amdgcn_sched_barrier(0)
    Unit cur, nxt; int ui = 0;
#ifdef DBG_NOGEMM
    return;
#endif
    if (!S.next(0, cur)) return;
    f32x4 acc[2][2][4][2];
#pragma unroll
    for (int a = 0; a < 2; ++a)
#pragma unroll
        for (int b = 0; b < 2; ++b)
#pragma unroll
            for (int m = 0; m < 4; ++m)
#pragma unroll
                for (int n = 0; n < 2; ++n) acc[a][b][m][n] = (f32x4){0.f, 0.f, 0.f, 0.f};
    bf16x8 At[4][2], B0[2][2], B1[2][2];
    const char* cA = (const char*)g.A + (size_t)cur.pm * tA + (size_t)cur.k0 * 2; const char* cB = (const char*)g.Bt + (size_t)cur.pn * tB + (size_t)cur.k0 * 2;
    PG8_STAGE(PG8_SB(0, 0), cB, voffB); PG8_STAGE(PG8_SB(0, 1), cB + hB, voffB); PG8_STAGE(PG8_SA(0, 0), cA, voffA); PG8_STAGE(PG8_SA(0, 1), cA + hA, voffA);
    if (wr == 1) PG8_BAR;
    PG8_WAIT_V(2); PG8_BAR;
    PG8_STAGE(PG8_SB(1, 0), cB + kstep, voffB); PG8_STAGE(PG8_SA(1, 0), cA + kstep, voffA); PG8_STAGE(PG8_SB(1, 1), cB + hB + kstep, voffB);
    PG8_WAIT_V(6); PG8_BAR;
    for (;;) {
        const bool has_next = S.next(ui + 1, nxt);
        const char* nA = has_next ? (const char*)g.A + (size_t)nxt.pm * tA + (size_t)nxt.k0 * 2 : cA; const char* nB = has_next ? (const char*)g.Bt + (size_t)nxt.pn * tB + (size_t)nxt.k0 * 2 : cB;
        const int nt = cur.nt;
#pragma unroll 1
        for (int t = 0; t < nt; t += 2) {
            const bool last = (t == nt - 2);
            const char* a1 = cA + (size_t)(t + 1) * kstep;
            const char* a2 = last ? nA : cA + (size_t)(t + 2) * kstep; const char* b2 = last ? nB : cB + (size_t)(t + 2) * kstep;
            const char* a3 = a2 + kstep; const char* b3 = b2 + kstep;
            PG8_LDB(B0, 0, 0); PG8_LDB(B1, 0, 1); PG8_SCHED; PG8_LDA(At, 0, 0); PG8_STAGE(PG8_SA(1, 1), a1 + hA, voffA);
            PG8_WAIT_V(8); PG8_WAIT_L(0); PG8_BAR; PG8_MMA(0, 0, At, B0); PG8_MMA(0, 1, At, B1); PG8_BAR; PG8_SCHED;
            PG8_LDA(At, 0, 1); PG8_STAGE(PG8_SB(0, 0), b2, voffB); PG8_STAGE(PG8_SB(0, 1), b2 + hB, voffB); PG8_STAGE(PG8_SA(0, 0), a2, voffA);
            PG8_WAIT_V(8); PG8_WAIT_L(0); PG8_BAR; PG8_MMA(1, 0, At, B0); PG8_MMA(1, 1, At, B1); PG8_BAR; PG8_SCHED;
            PG8_LDB(B0, 1, 0); PG8_LDB(B1, 1, 1); PG8_SCHED; PG8_LDA(At, 1, 0); PG8_STAGE(PG8_SA(0, 1), a2 + hA, voffA);
            PG8_WAIT_V(8); PG8_WAIT_L(0); PG8_BAR; PG8_MMA(0, 0, At, B0); PG8_MMA(0, 1, At, B1); PG8_BAR; PG8_SCHED;
            PG8_LDA(At, 1, 1); PG8_STAGE(PG8_SB(1, 0), b3, voffB); PG8_STAGE(PG8_SB(1, 1), b3 + hB, voffB); PG8_STAGE(PG8_SA(1, 0), a3, voffA);
            PG8_WAIT_V(8); PG8_WAIT_L(0); PG8_BAR; PG8_MMA(1, 0, At, B0); PG8_MMA(1, 1, At, B1); PG8_BAR; PG8_SCHED;
        }
        if constexpr (ALIGN_EPI) { if (wr == 0) PG8_BAR; }
        E(acc, cur, wr, wc, fr, fq);
        if (!has_next) break;
#pragma unroll
        for (int a = 0; a < 2; ++a)
#pragma unroll
            for (int b = 0; b < 2; ++b)
#pragma unroll
                for (int m = 0; m < 4; ++m)
#pragma unroll
                    for (int n = 0; n < 2; ++n) acc[a][b][m][n] = (f32x4){0.f, 0.f, 0.f, 0.f};
        cur = nxt; cA = nA; cB = nB; ++ui;
        if constexpr (ALIGN_EPI) { if (wr == 1) PG8_BAR; }
    }
    PG8_WAIT_V(0);
    if constexpr (!ALIGN_EPI) { if (wr == 0) PG8_BAR; }
    PG8_BAR;
#undef PG8_SA
#undef PG8_SB
#undef PG8_STAGE
#undef PG8_LDA
#undef PG8_LDB
#undef PG8_MMA
#undef PG8_WAIT_V
#undef PG8_WAIT_L
#undef PG8_BAR
#undef PG8_SCHED
}

typedef f32x4 AccT[2][2][4][2];
__device__ __forceinline__ u32x4 pack8(const f32x4 v0, const f32x4 v1) { u32x4 w; w.x = cvtpk(v0[0], v0[1]); w.y = cvtpk(v0[2], v0[3]); w.z = cvtpk(v1[0], v1[1]); w.w = cvtpk(v1[2], v1[3]); return w; }

struct EpiStore {
    bf16_t* O; int ldc;
    __device__ __forceinline__ void operator()(const AccT& acc, const Unit& u, int wr, int wc, int fr, int fq) const {
        const int row0 = u.pm * BM + wr * 64 + fr, col0 = u.pn * BM + wc * 32 + 8 * fq;
#pragma unroll
        for (int ai = 0; ai < 2; ++ai)
#pragma unroll
            for (int m = 0; m < 4; ++m) { bf16_t* rowp = O + (size_t)(row0 + ai * HALF + m * 16) * ldc + col0;
#pragma unroll
                for (int bj = 0; bj < 2; ++bj) *(u32x4*)(rowp + bj * HALF) = pack8(acc[ai][bj][m][0], acc[ai][bj][m][1]); }
    }
};
struct EpiInA {
    bf16_t* P; float* st_nk; float* st_nv; float* st_kr;
    __device__ __forceinline__ void operator()(const AccT& acc, const Unit& u, int wr, int wc, int fr, int fq) const {
        const int row0 = u.pm * BM + wr * 64 + fr, pn = u.pn, col0 = pn * BM + wc * 32 + 8 * fq;
        const bool ctx = u.pm < 16;
#pragma unroll
        for (int ai = 0; ai < 2; ++ai)
#pragma unroll
            for (int m = 0; m < 4; ++m) { const int row = row0 + ai * HALF + m * 16;
#pragma unroll
                for (int bj = 0; bj < 2; ++bj) {
                    if (pn == 8 && (bj != 0 || wc != 0)) continue;
                    const int col = col0 + bj * HALF; const f32x4 v0 = acc[ai][bj][m][0], v1 = acc[ai][bj][m][1];
                    *(u32x4*)(P + (size_t)row * LDP + col) = pack8(v0, v1);
                    if (ctx) {
                        float* d = nullptr;
                        if (pn == 4 || pn == 5) d = st_nk + (size_t)row * 512 + (col - 1024);
                        else if (pn == 6 || pn == 7) d = st_nv + (size_t)row * 512 + (col - 1536);
                        else if (pn == 8) d = st_kr + (size_t)row * 32 + (col - 2048);
                        if (d) { *(f32x4*)d = v0; *(f32x4*)(d + 4) = v1; }
                    }
                } }
    }
};
struct EpiInC {
    bf16_t* P; float* st_gv;
    __device__ __forceinline__ void operator()(const AccT& acc, const Unit& u, int wr, int wc, int fr, int fq) const {
        const int row0 = u.pm * BM + wr * 64 + fr, pn = u.pn, col0 = pn * BM + wc * 32 + 8 * fq;
        const bool st = (u.pm < 16) && (pn == 5);
#pragma unroll
        for (int ai = 0; ai < 2; ++ai)
#pragma unroll
            for (int m = 0; m < 4; ++m) { const int row = row0 + ai * HALF + m * 16;
#pragma unroll
                for (int bj = 0; bj < 2; ++bj) {
                    const int col = col0 + bj * HALF; const f32x4 v0 = acc[ai][bj][m][0], v1 = acc[ai][bj][m][1];
                    *(u32x4*)(P + (size_t)row * NINC + col) = pack8(v0, v1);
                    if (st) { float* d = st_gv + (size_t)row * 256 + (col - 1280); *(f32x4*)d = v0; *(f32x4*)(d + 4) = v1; }
                } }
    }
};
struct EpiRes {
    const float* srcLo; const float* srcHi; float* dst; const float* gate; bf16_t* part;
    __device__ __forceinline__ void operator()(const AccT& acc, const Unit& u, int wr, int wc, int fr, int fq) const {
        const int row0 = u.pm * BM + wr * 64 + fr, col0 = u.pn * BM + wc * 32 + 8 * fq;
        const int grp = u.pm < 16 ? 4 : ((u.pm - 16) >> 4);
        const float* gp = gate + grp * 6144 + col0;
        f32x4 gv[2][2];
#pragma unroll
        for (int bj = 0; bj < 2; ++bj) { gv[bj][0] = *(const f32x4*)(gp + bj * HALF); gv[bj][1] = *(const f32x4*)(gp + bj * HALF + 4); }
        const float* src = (u.pm < 16) ? srcLo : (srcHi - (size_t)MCTX * D);
#pragma unroll
        for (int ai = 0; ai < 2; ++ai)
#pragma unroll
            for (int m = 0; m < 4; ++m) { const size_t off = (size_t)(row0 + ai * HALF + m * 16) * D + col0;
#pragma unroll
                for (int bj = 0; bj < 2; ++bj) {
                    if (u.part) {
                        bf16_t* d = part + (size_t)(u.part - 1) * 4096 * 1024 + (off - (size_t)16384 * D) + bj * HALF;
                        *(u32x4*)d = pack8(gv[bj][0] * acc[ai][bj][m][0], gv[bj][1] * acc[ai][bj][m][1]);
                    } else {
                    const f32x4 x0 = *(const f32x4*)(src + off + bj * HALF), x1 = *(const f32x4*)(src + off + bj * HALF + 4);
                    *(f32x4*)(dst + off + bj * HALF) = x0 + gv[bj][0] * acc[ai][bj][m][0];
                    *(f32x4*)(dst + off + bj * HALF + 4) = x1 + gv[bj][1] * acc[ai][bj][m][1];
                    }
                } }
    }
};
struct EpiSwiglu {
    bf16_t* HF;
    __device__ __forceinline__ void operator()(const AccT& acc, const Unit& u, int wr, int wc, int fr, int fq) const {
        const int row0 = u.pm * BM + wr * 64 + fr, col0 = u.pn * HALF + wc * 32 + 8 * fq;
#pragma unroll
        for (int ai = 0; ai < 2; ++ai)
#pragma unroll
            for (int m = 0; m < 4; ++m) {
                f32x4 h[2];
#pragma unroll
                for (int n = 0; n < 2; ++n) { const f32x4 gt = acc[ai][0][m][n], up = acc[ai][1][m][n];
#pragma unroll
                    for (int e = 0; e < 4; ++e) { const float s = __builtin_amdgcn_rcpf(1.0f + __builtin_amdgcn_exp2f(-gt[e] * LOG2E)); h[n][e] = gt[e] * s * up[e]; } }
                *(u32x4*)(HF + (size_t)(row0 + ai * HALF + m * 16) * DFF + col0) = pack8(h[0], h[1]);
            }
    }
};
}

struct AttnArgs {
    const bf16_t* Q; int ldq;
    const bf16_t* Ka; int ldka; const bf16_t* Kb; int ldkb; const bf16_t* V; int ldv;
    bf16_t* O; int ldo;
    int qrow0;
    int seg0row, seg0n, seg1row, seg1n;
    float scale_log2;
    int rope; int tpos0;
    const float* cosT; const float* sinT; const float* qnorm;
    const float* rpb; int r0, rsmin;
};
__device__ __forceinline__ void glds16(const void* gsrc, unsigned lds_dst) { unsigned keep;
    asm volatile("s_mov_b32 %0, m0\n\ts_mov_b32 m0, %2\n\ts_nop 0\n\tglobal_load_lds_dwordx4 %1, off\n\ts_mov_b32 m0, %0" : "=&s"(keep) : "v"(gsrc), "s"(lds_dst) : "memory"); }
__device__ __forceinline__ float max3f(float a, float b, float c) { float r; asm("v_max3_f32 %0, %1, %2, %3" : "=v"(r) : "v"(a), "v"(b), "v"(c)); return r; }
__device__ __forceinline__ float max2f(float a, float b) { float r; asm("v_max_f32_e32 %0, %1, %2" : "=v"(r) : "v"(a), "v"(b)); return r; }
__device__ __forceinline__ int crow(int r, int hi) { return (r & 3) + 8 * (r >> 2) + 4 * hi; }

template <int DQK, int DV, int KSPLIT, int QMODE  , bool NA>
__device__ __forceinline__ void attn_unit(LAS unsigned char* lds, const AttnArgs& a, const int wid_in) {
    constexpr int KROW = (DQK > 64) ? 256 : 128, VROW = DV * 2;
    constexpr int KBUF = 64 * KROW, VBUF = 64 * VROW;
    constexpr int NKD = KBUF / 8192, NVD = VBUF / 8192;
    constexpr int ND0 = DQK / 16, NDB = DV / 32;
    constexpr int OFF_K = 0, OFF_V = 4 * KBUF, OFF_RPB = 4 * KBUF + 3 * VBUF;
    int tid_ = wid_in * 64 + lane_now(); asm volatile("" : "+v"(tid_));
    const int tid = tid_, lane = tid & 63, r32 = lane & 31, hi = lane >> 5;
    const int wid = __builtin_amdgcn_readfirstlane(tid >> 6);
    const int n0t = a.seg0n >> 6, NT = n0t + (a.seg1n >> 6);

    const bf16_t* kp[NKD]; int kst[NKD]; const bf16_t* vp[NVD];
#pragma unroll
    for (int i = 0; i < NKD; ++i) {
        int row, c;
        if (KROW == 256) { row = 8 * wid + 4 * i + (lane >> 4); c = (lane & 15) ^ (row & 15); }
        else { row = 8 * wid + (lane >> 3); c = (lane & 7) ^ ((row >> 1) & 7); }
        if (c >= DQK / 8) c = 0;
        if (c < KSPLIT) { kp[i] = a.Ka + (size_t)row * a.ldka + c * 8; kst[i] = a.ldka; }
        else { kp[i] = a.Kb + (size_t)row * a.ldkb + (c - KSPLIT) * 8; kst[i] = a.ldkb; }
    }
#pragma unroll
    for (int i = 0; i < NVD; ++i) {
        int row, c;
        if (VROW == 256) { row = 8 * wid + 4 * i + (lane >> 4); c = (lane & 15) ^ (4 * (row & 3)); }
        else { row = 8 * wid + (lane >> 3); c = (lane & 7) ^ (4 * ((row >> 1) & 1)); }
        vp[i] = a.V + (size_t)row * a.ldv + c * 8;
    }
    const unsigned lds0 = (unsigned)(uintptr_t)lds;
    auto tile_rb = [&](int t) { t = t < NT ? t : NT - 1; return (t < n0t) ? (a.seg0row + 64 * t) : (a.seg1row + 64 * (t - n0t)); };
    auto issueK = [&](int t, int slot) {
        const int rb = tile_rb(t);
#pragma unroll
        for (int i = 0; i < NKD; ++i)
            glds16(kp[i] + (size_t)rb * kst[i], (unsigned)__builtin_amdgcn_readfirstlane((int)(lds0 + OFF_K + slot * KBUF + (wid * NKD + i) * 1024)));
    };
    auto issueV = [&](int t, int slot) {
        const int rb = tile_rb(t);
#pragma unroll
        for (int i = 0; i < NVD; ++i)
            glds16(vp[i] + (size_t)rb * a.ldv, (unsigned)__builtin_amdgcn_readfirstlane((int)(lds0 + OFF_V + slot * VBUF + (wid * NVD + i) * 1024)));
    };

    issueK(0, 0); issueV(0, 0); issueK(1, 1); issueV(1, 1); issueK(2, 2);
    if (NA) { for (int i = tid; i < 465; i += 512) *(LAS float*)(lds + OFF_RPB + i * 4) = a.rpb[i] * LOG2E; }

    const int qrow = a.qrow0 + wid * 32 + r32;
    bf16x8 qf[ND0];
    {
        const bf16_t* qp = a.Q + (size_t)qrow * a.ldq + hi * 8;
        u32x4 qraw[ND0];
#pragma unroll
        for (int d0 = 0; d0 < ND0; ++d0) qraw[d0] = *(const u32x4*)(qp + d0 * 16);
        if (QMODE == 1) {
            if (a.rope) {
                const int tpos = a.tpos0 + wid * 32 + r32;
                const float* cp = a.cosT + (size_t)tpos * 16 + hi * 8; const float* sp = a.sinT + (size_t)tpos * 16 + hi * 8;
                const f32x4 c0 = *(const f32x4*)cp, c1 = *(const f32x4*)(cp + 4), s0 = *(const f32x4*)sp, s1 = *(const f32x4*)(sp + 4);
                float cc[8] = {c0[0], c0[1], c0[2], c0[3], c1[0], c1[1], c1[2], c1[3]}, ss[8] = {s0[0], s0[1], s0[2], s0[3], s1[0], s1[1], s1[2], s1[3]};
                u32x4 y1, y2;
#pragma unroll
                for (int w = 0; w < 4; ++w) {
                    const float a0 = bf_lo(qraw[4][w]), a1 = bf_hi(qraw[4][w]), b0 = bf_lo(qraw[5][w]), b1 = bf_hi(qraw[5][w]);
                    y1[w] = cvtpk(a0 * cc[2 * w] - b0 * ss[2 * w], a1 * cc[2 * w + 1] - b1 * ss[2 * w + 1]);
                    y2[w] = cvtpk(a0 * ss[2 * w] + b0 * cc[2 * w], a1 * ss[2 * w + 1] + b1 * cc[2 * w + 1]);
                }
                qraw[4] = y1; qraw[5] = y2;
            }
        }
        if (QMODE == 2) {
            float ssq = 0.f;
#pragma unroll
            for (int d0 = 0; d0 < ND0; ++d0)
#pragma unroll
                for (int w = 0; w < 4; ++w) { const float x0 = bf_lo(qraw[d0][w]), x1 = bf_hi(qraw[d0][w]); ssq += x0 * x0 + x1 * x1; }
            ssq = half_sum(ssq);
            const float rstd = a.scale_log2 / sqrtf(ssq * (1.0f / 128.0f) + RMS_EPS);
            const int tpos = a.tpos0 + wid * 32 + r32;
#pragma unroll
            for (int d0 = 0; d0 < 4; ++d0) {
                const float* g1 = a.qnorm + 16 * d0 + 8 * hi; const float* g2 = g1 + 64;
                const float* cp = a.cosT + (size_t)tpos * 64 + 16 * d0 + 8 * hi; const float* sp = a.sinT + (size_t)tpos * 64 + 16 * d0 + 8 * hi;
                f32x4 cv[2] = {(f32x4){1.f, 1.f, 1.f, 1.f}, (f32x4){1.f, 1.f, 1.f, 1.f}}, sv[2] = {(f32x4){0.f, 0.f, 0.f, 0.f}, (f32x4){0.f, 0.f, 0.f, 0.f}};
                if (a.rope) { cv[0] = *(const f32x4*)cp; cv[1] = *(const f32x4*)(cp + 4); sv[0] = *(const f32x4*)sp; sv[1] = *(const f32x4*)(sp + 4); }
                u32x4 y1, y2;
#pragma unroll
                for (int w = 0; w < 4; ++w) {
                    float a0 = bf_lo(qraw[d0][w]) * rstd * g1[2 * w], a1 = bf_hi(qraw[d0][w]) * rstd * g1[2 * w + 1];
                    float b0 = bf_lo(qraw[d0 + 4][w]) * rstd * g2[2 * w], b1 = bf_hi(qraw[d0 + 4][w]) * rstd * g2[2 * w + 1];
                    if (a.rope) {
                        const float c0 = cv[w >> 1][(2 * w) & 3], c1 = cv[w >> 1][(2 * w + 1) & 3], s0 = sv[w >> 1][(2 * w) & 3], s1 = sv[w >> 1][(2 * w + 1) & 3];
                        const float n0 = a0 * c0 - b0 * s0, n1 = a1 * c1 - b1 * s1, m0 = a0 * s0 + b0 * c0, m1 = a1 * s1 + b1 * c1;
                        a0 = n0; a1 = n1; b0 = m0; b1 = m1;
                    }
                    y1[w] = cvtpk(a0, a1); y2[w] = cvtpk(b0, b1);
                }
                qraw[d0] = y1; qraw[d0 + 4] = y2;
            }
        }
        if (QMODE != 2) {
#pragma unroll
            for (int d0 = 0; d0 < ND0; ++d0)
#pragma unroll
                for (int w = 0; w < 4; ++w) qraw[d0][w] = cvtpk(bf_lo(qraw[d0][w]) * a.scale_log2, bf_hi(qraw[d0][w]) * a.scale_log2);
        }
#pragma unroll
        for (int d0 = 0; d0 < ND0; ++d0) qf[d0] = __builtin_bit_cast(bf16x8, qraw[d0]);
    }

    f32x16 o[NDB];
#pragma unroll
    for (int i = 0; i < NDB; ++i) o[i] = f32x16{};
    constexpr bool NEGC = (DV == 64);
    float m_run = NEGC ? 0.f : -1e30f, l_run = 0.f;
    f32x16 negm16 = f32x16{};

    const int qr = NA ? (a.r0 + (wid >> 1)) : 0;
    const int qc = NA ? ((wid & 1) * 32 + r32) : 0;
    const int rs = NA ? min(max(qr - 4, 0), 56) : 0;
    const int cs = NA ? min(max(qc - 8, 0), 48) : 0;

    const int ksw = (KROW == 256) ? (r32 & 15) : ((r32 >> 1) & 7);
    const int ke = hi ^ ksw;
    const LAS unsigned char* krow = lds + OFF_K + r32 * KROW;
    auto qk = [&](int slot, f32x16& p0, f32x16& p1, const f32x16& cinit) {
        const LAS unsigned char* kb = krow + slot * KBUF;
#pragma unroll
        for (int d0 = 0; d0 < ND0; ++d0) {
            const int co = ((2 * d0) ^ ke) * 16;
            const bf16x8 k0 = *(const LAS bf16x8*)(kb + co);
            const bf16x8 k1 = *(const LAS bf16x8*)(kb + 32 * KROW + co);
            p0 = __builtin_amdgcn_mfma_f32_32x32x16_bf16(k0, qf[d0], d0 == 0 ? cinit : p0, 0, 0, 0);
            p1 = __builtin_amdgcn_mfma_f32_32x32x16_bf16(k1, qf[d0], d0 == 0 ? cinit : p1, 0, 0, 0);
        }
    };
    const int q4 = (lane & 15) >> 2, pp = lane & 3, blk = (lane >> 4) & 1;
    const int vsw = (VROW == 256) ? q4 : ((q4 >> 1) & 1);
    const int vlane_off = (4 * hi + q4) * VROW + 32 * blk + 8 * pp;
    constexpr float THR = 8.0f;
#define ATT_WAIT_BAR(N) do { asm volatile("s_waitcnt vmcnt(%0) lgkmcnt(0)" :: "n"(N) : "memory"); __builtin_amdgcn_s_barrier(); asm volatile("" ::: "memory"); } while (0)

    ATT_WAIT_BAR(2 * NKD + 2 * NVD);
    f32x16 p0, p1, n0, n1;
    qk(0, p0, p1, negm16);
    auto na_skip = [&](int t) { if (!NA || t < n0t || t >= NT) return false; const int kr = a.rsmin + (t - n0t); return (kr < rs) || (kr >= rs + 8); };
    int ks1 = 1, ks3 = 3, vs0 = 0, vs2 = 2;
    auto step = [&](int t, f32x16& p0, f32x16& p1, f32x16& n0, f32x16& n1) {
        ATT_WAIT_BAR(NKD + NVD);
        issueK(t + 3, ks3); issueV(t + 2, vs2);
        constexpr int HA = ND0 / 2;
        bf16x8 kA0[HA], kA1[HA];
        const LAS unsigned char* kbn = krow + ks1 * KBUF;
        if (!NA) {
#pragma unroll
            for (int d0 = 0; d0 < HA; ++d0) { const int co = ((2 * d0) ^ ke) * 16; kA0[d0] = *(const LAS bf16x8*)(kbn + co); kA1[d0] = *(const LAS bf16x8*)(kbn + 32 * KROW + co); }
            __builtin_amdgcn_sched_barrier(0);
        }
        const bool skip = na_skip(t);
        if (!skip) {
            if (NA && t >= n0t) {
                const int kr = a.rsmin + (t - n0t);
                const LAS float* bt = (const LAS float*)(lds + OFF_RPB) + (kr - qr + 7) * 31;
#pragma unroll
                for (int r = 0; r < 16; ++r) {
                    const int kc0 = crow(r, hi), kc1 = kc0 + 32;
                    const bool v0 = (kc0 >= cs) && (kc0 < cs + 16), v1 = (kc1 >= cs) && (kc1 < cs + 16);
                    const int i0 = min(max(kc0 - qc + 15, 0), 30), i1 = min(max(kc1 - qc + 15, 0), 30);
                    const float b0 = bt[i0], b1 = bt[i1];
                    p0[r] = v0 ? (p0[r] + b0) : -1e30f;
                    p1[r] = v1 ? (p1[r] + b1) : -1e30f;
                }
            }
            float mx = max2f(p0[0], p1[0]), mx2 = max2f(p0[1], p1[1]);
#pragma unroll
            for (int r = 2; r < 16; r += 2) { mx = max3f(mx, p0[r], p1[r]); mx2 = max3f(mx2, p0[r + 1], p1[r + 1]); }
            mx = max2f(mx, mx2);
            mx = half_max(mx);
            float negm = 0.f;
            if (NEGC) {
                if (t == 0 || __any(mx > THR)) {
                    const float dl = (t == 0) ? mx : fmaxf(mx, 0.f);
                    m_run += dl;
#pragma unroll
                    for (int r = 0; r < 16; ++r) { p0[r] -= dl; p1[r] -= dl; }
                    if (t != 0) {
                        const float f = __builtin_amdgcn_exp2f(-dl);
                        l_run *= f;
#pragma unroll
                        for (int i = 0; i < NDB; ++i)
#pragma unroll
                            for (int r = 0; r < 16; ++r) o[i][r] *= f;
                    }
#pragma unroll
                    for (int r = 0; r < 16; ++r) negm16[r] = -m_run;
                }
            } else {
                if (__any(mx > m_run + THR)) {
                    const float m_new = max2f(m_run, mx);
                    const float alpha = __builtin_amdgcn_exp2f(m_run - m_new);
                    m_run = m_new; l_run *= alpha;
#pragma unroll
                    for (int i = 0; i < NDB; ++i)
#pragma unroll
                        for (int r = 0; r < 16; ++r) o[i][r] *= alpha;
                }
                negm = -m_run;
            }
            if (!NA) {
#pragma unroll
                for (int d0 = 0; d0 < HA; ++d0) {
                    n0 = __builtin_amdgcn_mfma_f32_32x32x16_bf16(kA0[d0], qf[d0], d0 == 0 ? negm16 : n0, 0, 0, 0);
                    n1 = __builtin_amdgcn_mfma_f32_32x32x16_bf16(kA1[d0], qf[d0], d0 == 0 ? negm16 : n1, 0, 0, 0);
                }
                bf16x8 kB0[ND0 - HA], kB1[ND0 - HA];
#pragma unroll
                for (int d0 = HA; d0 < ND0; ++d0) { const int co = ((2 * d0) ^ ke) * 16; kB0[d0 - HA] = *(const LAS bf16x8*)(kbn + co); kB1[d0 - HA] = *(const LAS bf16x8*)(kbn + 32 * KROW + co); }
#pragma unroll
                for (int d0 = HA; d0 < ND0; ++d0) {
                    n0 = __builtin_amdgcn_mfma_f32_32x32x16_bf16(kB0[d0 - HA], qf[d0], n0, 0, 0, 0);
                    n1 = __builtin_amdgcn_mfma_f32_32x32x16_bf16(kB1[d0 - HA], qf[d0], n1, 0, 0, 0);
                }
            } else {
                if (!na_skip(t + 1)) qk(ks1, n0, n1, negm16);
            }
            {
                f32x2_t sum2 = {0.f, 0.f};
#pragma unroll
                for (int r = 0; r < 16; r += 2) {
                    f32x2_t a2 = {p0[r], p0[r + 1]}, b2 = {p1[r], p1[r + 1]};
                    if (!NEGC) { const f32x2_t nm2 = {negm, negm}; a2 += nm2; b2 += nm2; }
                    a2.x = __builtin_amdgcn_exp2f(a2.x); a2.y = __builtin_amdgcn_exp2f(a2.y); b2.x = __builtin_amdgcn_exp2f(b2.x); b2.y = __builtin_amdgcn_exp2f(b2.y);
                    sum2 += a2; sum2 += b2;
                    p0[r] = a2.x; p0[r + 1] = a2.y; p1[r] = b2.x; p1[r + 1] = b2.y;
                }
                l_run += sum2.x + sum2.y;
            }
            bf16x8 pa[4];
            {
                u32x4 w;
                w.x = cvtpk(p0[0], p0[1]); w.y = cvtpk(p0[2], p0[3]); w.z = cvtpk(p0[4], p0[5]); w.w = cvtpk(p0[6], p0[7]); pa[0] = __builtin_bit_cast(bf16x8, w);
                w.x = cvtpk(p0[8], p0[9]); w.y = cvtpk(p0[10], p0[11]); w.z = cvtpk(p0[12], p0[13]); w.w = cvtpk(p0[14], p0[15]); pa[1] = __builtin_bit_cast(bf16x8, w);
                w.x = cvtpk(p1[0], p1[1]); w.y = cvtpk(p1[2], p1[3]); w.z = cvtpk(p1[4], p1[5]); w.w = cvtpk(p1[6], p1[7]); pa[2] = __builtin_bit_cast(bf16x8, w);
                w.x = cvtpk(p1[8], p1[9]); w.y = cvtpk(p1[10], p1[11]); w.z = cvtpk(p1[12], p1[13]); w.w = cvtpk(p1[14], p1[15]); pa[3] = __builtin_bit_cast(bf16x8, w);
            }
            const LAS unsigned char* vb = lds + OFF_V + vs0 * VBUF + vlane_off;
#pragma unroll
            for (int ks = 0; ks < 4; ++ks)
#pragma unroll
                for (int db = 0; db < NDB; ++db) {
                    const LAS unsigned char* vq = vb + (16 * ks) * VROW + ((db ^ vsw) * 64);
                    const s16x4 lo = __builtin_bit_cast(s16x4, __builtin_amdgcn_ds_read_tr16_b64_v4i16((LAS s16x4*)(vq)));
                    const s16x4 hh = __builtin_bit_cast(s16x4, __builtin_amdgcn_ds_read_tr16_b64_v4i16((LAS s16x4*)(vq + 8 * VROW)));
                    const bf16x8 vf = (bf16x8){lo[0], lo[1], lo[2], lo[3], hh[0], hh[1], hh[2], hh[3]};
                    o[db] = __builtin_amdgcn_mfma_f32_32x32x16_bf16(vf, pa[ks], o[db], 0, 0, 0);
                }
        } else { if (NA && !na_skip(t + 1)) qk(ks1, n0, n1, negm16); }
        ks1 = (ks1 + 1) & 3; ks3 = (ks3 + 1) & 3; vs0 = (vs0 == 2) ? 0 : vs0 + 1; vs2 = (vs2 == 2) ? 0 : vs2 + 1;
    };
    {
        int t = 0;
        for (; t + 1 < NT; t += 2) { step(t, p0, p1, n0, n1); step(t + 1, n0, n1, p0, p1); }
        if (t < NT) step(t, p0, p1, n0, n1);
    }
    const float lt = half_sum(l_run);
    const float inv = 1.0f / lt;
    ATT_WAIT_BAR(0);
    {
        constexpr int OP = DV * 2 + 8;
        int lane2 = lane; asm volatile("" : "+v"(lane2));
        const int e32 = lane2 & 31, ehi = lane2 >> 5;
        LAS unsigned char* stg = lds + wid * (32 * OP);
#pragma unroll
        for (int db = 0; db < NDB; ++db)
#pragma unroll
            for (int r4 = 0; r4 < 4; ++r4) {
                u32x2 w; w.x = cvtpk(o[db][4 * r4] * inv, o[db][4 * r4 + 1] * inv); w.y = cvtpk(o[db][4 * r4 + 2] * inv, o[db][4 * r4 + 3] * inv);
                *(LAS u32x2*)(stg + e32 * OP + (32 * db + 8 * r4 + 4 * ehi) * 2) = w;
            }
        constexpr int CH = DV / 8, RPI = 64 / CH;
        bf16_t* ob = a.O + (size_t)(a.qrow0 + wid * 32) * a.ldo;
#pragma unroll
        for (int i = 0; i < 32 / RPI; ++i) {
            const int row = i * RPI + lane2 / CH, ch = lane2 % CH;
            const u32x2 lo = *(const LAS u32x2*)(stg + row * OP + ch * 16), hh = *(const LAS u32x2*)(stg + row * OP + ch * 16 + 8);
            *(u32x4*)(ob + (size_t)row * a.ldo + ch * 8) = (u32x4){lo.x, lo.y, hh.x, hh.y};
        }
    }
    ATT_WAIT_BAR(0);
#undef ATT_WAIT_BAR
}

struct KArgs { const float* in[28]; float* out; unsigned char* ws; };

__device__ __forceinline__ void transpose_item(const float* W, int K, int N, bf16_t* WT, int mapmode, LAS float* scr, int item, int lane) {
    const int nblk = N / 32, kb = item / nblk, nb = item % nblk, k0 = 64 * kb, n0 = 32 * nb;
    int d0 = n0;
    if (mapmode == 1) {
        if (n0 < 512) d0 = n0; else if (n0 < 544) d0 = 2048 + (n0 - 512); else d0 = n0 - 32;
    } else if (mapmode == 2) {
        if (n0 < DFF) d0 = (n0 >> 7) * 256 + (n0 & 127); else { const int j = n0 - DFF; d0 = (j >> 7) * 256 + 128 + (j & 127); }
    }
#pragma unroll 8
    for (int i = 0; i < 32; ++i) { const int kk = 2 * i + (lane >> 5); scr[kk * 33 + (lane & 31)] = W[(size_t)(k0 + kk) * N + n0 + (lane & 31)]; }
    asm volatile("s_waitcnt lgkmcnt(0)" ::: "memory");
    const int c = lane & 7;
#pragma unroll
    for (int j = 0; j < 4; ++j) { const int n = (lane >> 3) + 8 * j; const LAS float* s = scr + (8 * c) * 33 + n;
        u32x4 o; o.x = cvtpk(s[0 * 33], s[1 * 33]); o.y = cvtpk(s[2 * 33], s[3 * 33]); o.z = cvtpk(s[4 * 33], s[5 * 33]); o.w = cvtpk(s[6 * 33], s[7 * 33]);
        *(u32x4*)(WT + (size_t)(d0 + n) * K + k0 + 8 * c) = o; }
    asm volatile("s_waitcnt lgkmcnt(0)" ::: "memory");
}

__device__ __forceinline__ void tjob(const float* W, int K, int N, bf16_t* WT, int map, int& base, LAS unsigned char* lds, int gw, int NGW, int wid, int lane) {
    asm volatile("" : "+v"(lane));
    LAS float* scr = (LAS float*)(lds + wid * 16384);
    const int items = (K / 64) * (N / 32);
    const int first = ((gw - base) % NGW + NGW) % NGW;
    for (int it = first; it < items; it += NGW) transpose_item(W, K, N, WT, map, scr, it, lane);
    base += items;
}

__device__ __forceinline__ void norm_mod_rows(const float* srcLo, const float* srcHi, const float* g, const float* modl, int shi, int sci, bf16_t* H, int gw, int NGW, int lane_in, const bf16_t* part = nullptr, float* xwb = nullptr, const float* srcSplit = nullptr) {
    int lane = lane_in; asm volatile("" : "+v"(lane));
    for (int row0 = gw; row0 < MTOK; row0 += 2 * NGW) {
        f32x4 v[2][4]; int rows[2]; bool ok[2];
#pragma unroll
        for (int q = 0; q < 2; ++q) {
            const int row = row0 + q * NGW; rows[q] = row; ok[q] = row < MTOK;
            if (ok[q]) { const float* xr = (row < MCTX) ? srcLo + (size_t)row * D : srcHi + (size_t)(row - MCTX) * D;
                if (srcSplit != nullptr && row >= 16384) xr = srcSplit + (size_t)(row - 16384) * D;
#pragma unroll
                for (int j = 0; j < 4; ++j) v[q][j] = *(const f32x4*)(xr + 4 * lane + 256 * j); }
        }
#pragma unroll
        for (int q = 0; q < 2; ++q) {
            if (!ok[q]) continue;
            const int row = rows[q];
            if (part != nullptr && row >= 16384) {
#pragma unroll
                for (int p = 0; p < 4; ++p)
#pragma unroll
                    for (int j = 0; j < 4; ++j) { const u32x2 w = *(const u32x2*)(part + ((size_t)p * 4096 + (row - 16384)) * 1024 + 4 * lane + 256 * j);
                        v[q][j][0] += bf_lo(w.x); v[q][j][1] += bf_hi(w.x); v[q][j][2] += bf_lo(w.y); v[q][j][3] += bf_hi(w.y); }
#pragma unroll
                for (int j = 0; j < 4; ++j) *(f32x4*)(xwb + (size_t)row * D + 4 * lane + 256 * j) = v[q][j];
            }
            const int grp = row < MCTX ? 4 : ((row - MCTX) >> 12);
            const float* sh = modl + grp * 6144 + shi * 1024; const float* sc = modl + grp * 6144 + sci * 1024;
            float s = 0.f;
#pragma unroll
            for (int j = 0; j < 4; ++j) s += v[q][j][0] * v[q][j][0] + v[q][j][1] * v[q][j][1] + v[q][j][2] * v[q][j][2] + v[q][j][3] * v[q][j][3];
            const float rstd = 1.0f / sqrtf(wave_sum(s, lane) * (1.0f / D) + RMS_EPS);
#pragma unroll
            for (int j = 0; j < 4; ++j) {
                const int c = 4 * lane + 256 * j;
                const f32x4 gg = *(const f32x4*)(g + c), s1 = *(const f32x4*)(sc + c), s0 = *(const f32x4*)(sh + c);
                f32x4 y;
#pragma unroll
                for (int e = 0; e < 4; ++e) y[e] = v[q][j][e] * rstd * gg[e] * (1.0f + s1[e]) + s0[e];
                u32x2 w; w.x = cvtpk(y[0], y[1]); w.y = cvtpk(y[2], y[3]);
                *(u32x2*)(H + (size_t)row * D + c) = w;
            }
        }
    }
}

#define XB_TMO      128
#define XB_XCNT(j)  (256  + 64 * (j))
#define XB_XSUB(j)  (1280 + 64 * (j))
#define XB_XGEN(j)  (2304 + 64 * (j))
#define XB_TOP      3328
#define XB_TOPGEN   3392
#define XCD_BAR_WORDS 3456
#define XB_SPIN_CAP (1u << 18)
__device__ __forceinline__ unsigned xb_ld(unsigned* p)              { return __hip_atomic_load(p, __ATOMIC_RELAXED, __HIP_MEMORY_SCOPE_AGENT); }
__device__ __forceinline__ unsigned xb_add(unsigned* p, unsigned v) { return __hip_atomic_fetch_add(p, v, __ATOMIC_RELAXED, __HIP_MEMORY_SCOPE_AGENT); }
__device__ __forceinline__ unsigned xb_xcc_id() { return (unsigned)__builtin_amdgcn_s_getreg((3 << 11) | 20) & 0xFu; }
#define XB_SPIN(cond, bar) do { unsigned _sp = 0; while (cond) { __builtin_amdgcn_s_sleep(1); \
    if ((++_sp & 255u) == 0u) { if (xb_ld(&(bar)[XB_TMO])) break; if (_sp > XB_SPIN_CAP) { atomicAdd(&(bar)[XB_TMO], 1u); break; } } } } while (0)
struct XcdBarrier { unsigned* bar; unsigned x; volatile LAS unsigned* st; int wid; };
__device__ __forceinline__ XcdBarrier xcd_barrier_post(unsigned* bar, volatile LAS unsigned* st, int wid) {
    XcdBarrier b; b.bar = bar; b.x = xb_xcc_id(); b.st = st; b.wid = wid;
    int t0 = wid * 64 + lane_now(); asm volatile("" : "+v"(t0));
    if (t0 == 0) (void)xb_add(&bar[XB_XCNT(b.x)], 1u);
    return b;
}
__device__ __forceinline__ void xcd_barrier_complete(unsigned* bar, unsigned x, unsigned& nloc, unsigned& nx) {
    const unsigned G = gridDim.x * gridDim.y * gridDim.z;
    unsigned sum, cnt, mine, sp = 0u;
    for (;;) {
        sum = 0u; cnt = 0u; mine = 0u;
#pragma unroll
        for (unsigned j = 0; j < 16; ++j) { const unsigned c = xb_ld(&bar[XB_XCNT(j)]); sum += c; cnt += (c > 0u) ? 1u : 0u; mine = (j == x) ? c : mine; }
        if (sum == G) break;
        __builtin_amdgcn_s_sleep(1);
        if ((++sp & 255u) == 0u) { if (xb_ld(&bar[XB_TMO])) break; if (sp > XB_SPIN_CAP) { atomicAdd(&bar[XB_TMO], 1u); break; } }
    }
    nloc = mine > 0u ? mine : 1u; nx = cnt > 0u ? cnt : 1u;
}
__device__ __forceinline__ void xcd_barrier(const XcdBarrier& b) {
    asm volatile("s_waitcnt vmcnt(0)" ::: "memory");
    __syncthreads();
    int t0 = b.wid * 64 + lane_now(); asm volatile("" : "+v"(t0));
    if (t0 == 0) {
        unsigned* bar = b.bar; unsigned bx = b.x; asm volatile("" : "+s"(bar), "+s"(bx));
        __builtin_amdgcn_s_waitcnt(0);
        unsigned nloc = b.st[0], nx = b.st[1];
        if (nloc == 0u) { xcd_barrier_complete(bar, bx, nloc, nx); b.st[0] = nloc; b.st[1] = nx; }
        const unsigned old = xb_add(&bar[XB_XSUB(bx)], 1u);
        const unsigned gen = old / nloc;
        if (old + 1u == (gen + 1u) * nloc) {
            __builtin_amdgcn_fence(__ATOMIC_RELEASE, "agent");
            asm volatile("s_waitcnt vmcnt(0)" ::: "memory");
            const unsigned og = xb_add(&bar[XB_TOP], 1u);
            const unsigned tg = og / nx;
            if (og + 1u == (tg + 1u) * nx) xb_add(&bar[XB_TOPGEN], 1u);
            else XB_SPIN(xb_ld(&bar[XB_TOPGEN]) == tg, bar);
            __builtin_amdgcn_fence(__ATOMIC_ACQUIRE, "agent");
            xb_add(&bar[XB_XGEN(bx)], 1u);
            asm volatile("s_waitcnt vmcnt(0)" ::: "memory");
        } else {
            XB_SPIN(xb_ld(&bar[XB_XGEN(bx)]) == gen, bar);
            __builtin_amdgcn_fence(__ATOMIC_ACQUIRE, "agent");
            asm volatile("s_waitcnt vmcnt(0)" ::: "memory");
        }
    }
    __syncthreads();
}

constexpr int LDS_PTRS = 131072 + 1024;
__device__ __forceinline__ const float* ldsptr(LAS unsigned char* lds, int i) {
    int off = LDS_PTRS + 8 * i; asm volatile("" : "+v"(off));
    const LAS unsigned* p = (const LAS unsigned*)(lds + off);
    const unsigned lo = __builtin_amdgcn_readfirstlane(p[0]), hi = __builtin_amdgcn_readfirstlane(p[1]);
    return (const float*)(const __attribute__((address_space(1))) float*)(((unsigned long long)hi << 32) | lo);
}
#define AIN(k) ldsptr(lds, (k))
#define PH_RELOAD do { asm volatile("" : "+s"(gw), "+s"(bid), "+s"(G), "+s"(NGW)); ws = (unsigned char*)ldsptr(lds, 29); out = (float*)ldsptr(lds, 28); modv = (float*)(ws + WS_MOD); \
    cosM = (float*)(ws + WS_COSM); sinM = (float*)(ws + WS_SINM); cosG = (float*)(ws + WS_COSG); sinG = (float*)(ws + WS_SING); \
    HO = (bf16_t*)(ws + WS_HO); P = (bf16_t*)(ws + WS_P); QM = (bf16_t*)(ws + WS_QM); KV = (bf16_t*)(ws + WS_KV); KR = (bf16_t*)(ws + WS_KR); \
    HF = (bf16_t*)(ws + WS_HF); P2 = (bf16_t*)(ws + WS_P2); KG = (bf16_t*)(ws + WS_KG); VG = (bf16_t*)(ws + WS_VG); x_prompt = AIN(0); x_sample = AIN(1); } while (0)

__global__ void __launch_bounds__(512) fwd_kernel(KArgs args) {
    extern __shared__ __attribute__((aligned(16))) unsigned char lds_raw[];
    LAS unsigned char* lds = (LAS unsigned char*)lds_raw;
    cg::grid_group grid = cg::this_grid();
    const int wid = __builtin_amdgcn_readfirstlane((int)threadIdx.x >> 6);
#define lane0 lane_now()
#define tid0 (wid * 64 + lane_now())
    int G = gridDim.x, bid = blockIdx.x;
    int gw = bid * 8 + wid, NGW = G * 8;
    unsigned char* ws = args.ws;
    float* out = args.out;
    const float* modl = nullptr;
    float* modv = (float*)(ws + WS_MOD);
    float* cosM = (float*)(ws + WS_COSM); float* sinM = (float*)(ws + WS_SINM);
    float* cosG = (float*)(ws + WS_COSG); float* sinG = (float*)(ws + WS_SING);
    bf16_t* HO = (bf16_t*)(ws + WS_HO);
    bf16_t* P = (bf16_t*)(ws + WS_P);
    bf16_t* QM = (bf16_t*)(ws + WS_QM);
    bf16_t* KV = (bf16_t*)(ws + WS_KV);
    bf16_t* KR = (bf16_t*)(ws + WS_KR);
    bf16_t* HF = (bf16_t*)(ws + WS_HF);
    bf16_t* P2 = (bf16_t*)(ws + WS_P2);
    bf16_t* KG = (bf16_t*)(ws + WS_KG);
    bf16_t* VG = (bf16_t*)(ws + WS_VG);
    const float* x_prompt = args.in[0]; const float* x_sample = args.in[1];
    int t00 = tid0; asm volatile("" : "+v"(t00));
    if (t00 == 0) {
        LAS unsigned long long* pp = (LAS unsigned long long*)(lds + LDS_PTRS);
#pragma unroll
        for (int k = 0; k < 28; ++k) pp[k] = (unsigned long long)args.in[k];
        pp[28] = (unsigned long long)args.out; pp[29] = (unsigned long long)args.ws;
    }

    if (args.ws == nullptr) grid.sync();
    if (tid0 < 2) *(volatile LAS unsigned*)(lds + 131072 + 512 + 4 * tid0) = 0u;
    __syncthreads();
    const XcdBarrier xbar = xcd_barrier_post((unsigned*)(ws + WS_BAR), (volatile LAS unsigned*)(lds + 131072 + 512), wid);
    {
        int tid = tid0; asm volatile("" : "+v"(tid)); const int lane = tid & 63;
        int tb = 0;
        tjob(args.in[15], 1024, 2080, (bf16_t*)(ws + WS_WINA), 1, tb, lds, gw, NGW, wid, lane);
        tjob(args.in[17], 256, 768, (bf16_t*)(ws + WS_WUQ), 0, tb, lds, gw, NGW, wid, lane);
        tjob(args.in[19], 256, 1024, (bf16_t*)(ws + WS_WUKV), 0, tb, lds, gw, NGW, wid, lane);
        tjob(args.in[21], 1024, 1024, (bf16_t*)(ws + WS_WOUTA), 0, tb, lds, gw, NGW, wid, lane);
        tjob(args.in[26], 1024, 2 * DFF, (bf16_t*)(ws + WS_WF1_0), 2, tb, lds, gw, NGW, wid, lane);
        tjob(args.in[27], DFF, 1024, (bf16_t*)(ws + WS_WF2_0), 0, tb, lds, gw, NGW, wid, lane);
        { u32x4* z = (u32x4*)((bf16_t*)(ws + WS_WINA) + (size_t)2080 * 1024); const int n16 = 224 * 1024 * 2 / 16;
          for (int i = bid * 512 + tid; i < n16; i += G * 512) z[i] = (u32x4){0u, 0u, 0u, 0u}; }
        for (int i = bid * 512 + tid; i < 4096 * 80; i += G * 512) {
            int t, j, pos; float ex;
            if (i < 4096 * 16) { t = i >> 4; j = i & 15; pos = (j < 8) ? (t >> 6) : (t & 63); ex = (float)(2 * (j & 7)) * (1.0f / 16.0f); }
            else { const int i2 = i - 4096 * 16; t = i2 >> 6; j = i2 & 63; pos = (j < 32) ? (t >> 6) : (t & 63); ex = (float)(2 * (j & 31)) * (1.0f / 64.0f); }
            const float x = exp2f(-ex * 13.287712379549449f), x2 = x * x;
            float cb = 1.0f + x2 * (-0.5f + x2 * (4.1666666666666664e-2f + x2 * (-1.3888888888888889e-3f + x2 * (2.4801587301587302e-5f + x2 * (-2.7557319223985888e-7f)))));
            float sb = x * (1.0f + x2 * (-1.6666666666666666e-1f + x2 * (8.3333333333333332e-3f + x2 * (-1.9841269841269841e-4f + x2 * (2.7557319223985893e-6f + x2 * (-2.5052108385441720e-8f))))));
            float rc = 1.0f, rs = 0.0f;
#pragma unroll
            for (int bb = 0; bb < 6; ++bb) {
                if (pos & (1 << bb)) { const float tt = rc * cb - rs * sb; rs = rc * sb + rs * cb; rc = tt; }
                const float t2 = cb * cb - sb * sb; sb = 2.0f * cb * sb; cb = t2;
            }
            if (i < 4096 * 16) { cosM[i] = rc; sinM[i] = rs; } else { cosG[i - 4096 * 16] = rc; sinG[i - 4096 * 16] = rs; }
        }
        for (int j = gw; j < 1024; j += NGW) {
            const size_t row = MTOK + j;
            { const f32x4 v = *(const f32x4*)(args.in[2] + (size_t)j * 256 + 4 * lane); u32x2 w; w.x = cvtpk(v[0], v[1]); w.y = cvtpk(v[2], v[3]); *(u32x2*)(P + row * LDP + 256 + 4 * lane) = w; }
#pragma unroll
            for (int q = 0; q < 2; ++q) {
                const f32x4 v = *(const f32x4*)(args.in[4] + (size_t)j * 512 + 256 * q + 4 * lane); u32x2 w; w.x = cvtpk(v[0], v[1]); w.y = cvtpk(v[2], v[3]); *(u32x2*)(P + row * LDP + 1024 + 256 * q + 4 * lane) = w;
                const f32x4 u = *(const f32x4*)(args.in[5] + (size_t)j * 512 + 256 * q + 4 * lane); u32x2 w2; w2.x = cvtpk(u[0], u[1]); w2.y = cvtpk(u[2], u[3]); *(u32x2*)(P + row * LDP + 1536 + 256 * q + 4 * lane) = w2;
            }
            if (lane < 16) { const float v0 = args.in[3][(size_t)j * 32 + 2 * lane], v1 = args.in[3][(size_t)j * 32 + 2 * lane + 1]; *(unsigned*)(KR + row * 32 + 2 * lane) = cvtpk(v0, v1); }
        }
        __syncthreads();
        if (bid < 192) {
            const int l = bid / 96, col0 = (bid % 96) * 64;
            LAS float* scond = (LAS float*)lds;
            LAS float* red = (LAS float*)(lds + 20480);
            for (int i = tid; i < 5 * 1024; i += 512) { const int gI = i >> 10, k = i & 1023; const float x = (gI < 4) ? args.in[8][gI * 1024 + k] : args.in[9][k]; scond[i] = x / (1.0f + expf(-x)); }
            __syncthreads();
            const int cq = tid & 15, kl = tid >> 4;
            f32x4 acc[5];
#pragma unroll
            for (int gI = 0; gI < 5; ++gI) acc[gI] = (f32x4){0.f, 0.f, 0.f, 0.f};
            const float* wp = args.in[10] + (size_t)l * 1024 * 6144 + col0 + 4 * cq;
#pragma unroll 2
            for (int k = kl; k < 1024; k += 32) {
                const f32x4 w = *(const f32x4*)(wp + (size_t)k * 6144);
#pragma unroll
                for (int gI = 0; gI < 5; ++gI) acc[gI] += w * scond[gI * 1024 + k];
            }
#pragma unroll
            for (int gI = 0; gI < 5; ++gI) *(LAS f32x4*)(red + (kl * 5 + gI) * 64 + 4 * cq) = acc[gI];
            __syncthreads();
            if (tid < 320) { const int gI = tid >> 6, c = tid & 63; float s = args.in[11][l * 6144 + col0 + c];
                for (int k2 = 0; k2 < 32; ++k2) s += red[(k2 * 5 + gI) * 64 + c];
                modv[(l * 5 + gI) * 6144 + col0 + c] = s; }
            __syncthreads();
        }
    }
    xcd_barrier(xbar); PH_RELOAD;

#pragma unroll
    for (int l = 0; l < 2; ++l) {
        PH_RELOAD; modl = modv + l * 5 * 6144;
        if (l == 0) norm_mod_rows(x_prompt, x_sample, AIN(12), modl, 0, 1, HO, gw, NGW, lane0);
        else norm_mod_rows(out, out + (size_t)MCTX * D, AIN(12) + 1024, modl, 0, 1, HO, gw, NGW, lane0, (G == 256) ? (const bf16_t*)(ws + WS_PART) : nullptr, out);
        xcd_barrier(xbar); PH_RELOAD; modl = modv + l * 5 * 6144;

        if (l == 0) {
            {
                pg8::Gemm g{HO, (const bf16_t*)(ws + WS_WINA), MTOK, NINA, 1024, 1024, 1024};
                pg8::StaticOrder S; S.init(MTOK, NINA, G, bid, 1024);
                pg8::EpiInA E{P, out + O_NAK, out + O_NAV, out + O_KROPE};
                if (DBG_GM & 1) pg8::gemm_phase<pg8::EpiInA, true>(lds, g, S, E, wid);
            }
            xcd_barrier(xbar); PH_RELOAD; modl = modv + l * 5 * 6144;
            int lane = lane0; asm volatile("" : "+v"(lane));
            for (int row = gw; row < MTOK; row += NGW) {
                bf16_t* pr = P + (size_t)row * LDP;
                const u32x2 a = *(const u32x2*)(pr + 4 * lane), b = *(const u32x2*)(pr + 256 + 4 * lane);
                float x[4] = {bf_lo(a.x), bf_hi(a.x), bf_lo(a.y), bf_hi(a.y)}, y[4] = {bf_lo(b.x), bf_hi(b.x), bf_lo(b.y), bf_hi(b.y)};
                const float sx = wave_sum(x[0] * x[0] + x[1] * x[1] + x[2] * x[2] + x[3] * x[3], lane);
                const float sy = wave_sum(y[0] * y[0] + y[1] * y[1] + y[2] * y[2] + y[3] * y[3], lane);
                const float rx = 1.0f / sqrtf(sx * (1.0f / 256.0f) + RMS_EPS), ry = 1.0f / sqrtf(sy * (1.0f / 256.0f) + RMS_EPS);
                const f32x4 gq = *(const f32x4*)(AIN(16) + 4 * lane), gk = *(const f32x4*)(AIN(18) + 4 * lane);
                f32x4 xn, yn;
#pragma unroll
                for (int e = 0; e < 4; ++e) { xn[e] = x[e] * rx * gq[e]; yn[e] = y[e] * ry * gk[e]; }
                u32x2 w; w.x = cvtpk(xn[0], xn[1]); w.y = cvtpk(xn[2], xn[3]); *(u32x2*)(pr + 4 * lane) = w;
                w.x = cvtpk(yn[0], yn[1]); w.y = cvtpk(yn[2], yn[3]); *(u32x2*)(pr + 256 + 4 * lane) = w;
                if (row < MCTX) *(f32x4*)(out + O_CKV + (size_t)row * 256 + 4 * lane) = yn;
                if (lane < 16) {
                    float x1 = __uint_as_float((unsigned)pr[2048 + lane] << 16), x2 = __uint_as_float((unsigned)pr[2064 + lane] << 16);
                    if (row >= MCTX) { const int t = (row - MCTX) & 4095; const float c = cosM[t * 16 + lane], s = sinM[t * 16 + lane];
                        const float n1 = x1 * c - x2 * s, n2 = x1 * s + x2 * c; x1 = n1; x2 = n2; }
                    KR[(size_t)row * 32 + lane] = (bf16_t)(cvtpk(x1, 0.f) & 0xffffu); KR[(size_t)row * 32 + 16 + lane] = (bf16_t)(cvtpk(x2, 0.f) & 0xffffu);
                }
            }
            xcd_barrier(xbar); PH_RELOAD; modl = modv + l * 5 * 6144;
            {
                pg8::Gemm g{P, (const bf16_t*)(ws + WS_WUQ), MTOK, 768, 256, LDP, 256};
                pg8::StaticOrder S; S.init(g.M, g.N, G, bid, 256);
                pg8::EpiStore E{QM, 768};
                if (DBG_GM & 2) pg8::gemm_phase<pg8::EpiStore, true>(lds, g, S, E, wid);
            }
            {
                pg8::Gemm g{P + 256, (const bf16_t*)(ws + WS_WUKV), MALL, 1024, 256, LDP, 256};
                pg8::StaticOrder S; S.init(g.M, g.N, G, bid, 256);
                pg8::EpiStore E{KV, 1024};
                if (DBG_GM & 2) pg8::gemm_phase<pg8::EpiStore, true>(lds, g, S, E, wid);
            }
            xcd_barrier(xbar); PH_RELOAD; modl = modv + l * 5 * 6144;
            {
                bf16_t* O = HO;
                const float mla_sc = 0.10206207261596575f * LOG2E, na_sc = 0.125f * LOG2E;
                int bidl = bid; asm volatile("" : "+s"(bidl));
                const bool xmap = (G == 256); const int xcd = bidl & 7, jb = bidl >> 3;
                for (int u = bidl; u < 1280; u += G) {
                    AttnArgs a{};
                    a.O = nullptr;
                    if (u < 512) {
                        const int v = jb + 32 * (u >> 8), b = xmap ? (xcd >> 1) : (u >> 7), h = xmap ? ((xcd & 1) * 4 + (v >> 4)) : ((u >> 4) & 7), qb = xmap ? (v & 15) : (u & 15);
                        a.Q = QM + h * 96; a.ldq = 768; a.Ka = KV + h * 128; a.ldka = 1024; a.Kb = KR; a.ldkb = 32; a.V = KV + h * 128 + 64; a.ldv = 1024;
                        a.O = O + h * 64; a.ldo = 1024; a.qrow0 = MCTX + b * 4096 + qb * 256; a.seg0row = MCTX + b * 4096; a.seg0n = 4096; a.seg1row = MTOK + b * 256; a.seg1n = 256;
                        a.scale_log2 = mla_sc; a.rope = 1; a.tpos0 = qb * 256; a.cosT = cosM; a.sinT = sinM;
                        attn_unit<96, 64, 8, 1, false>(lds, a, wid);
                    } else if (u < 1024) {
                        const int w = u - 512, v = jb + 32 * (w >> 8), b = xmap ? (xcd >> 1) : (w >> 7), h = xmap ? ((xcd & 1) * 4 + (v >> 4)) : ((w >> 4) & 7), qb = xmap ? (v & 15) : (w & 15), r0 = 4 * qb;
                        const int rsmin = min(max(r0 - 4, 0), 56), rsmax = min(max(r0 + 3 - 4, 0), 56), nb = rsmax + 8 - rsmin;
                        a.Q = P + 512 + h * 64; a.ldq = LDP; a.Ka = P + 1024 + h * 64; a.ldka = LDP; a.Kb = a.Ka; a.ldkb = LDP; a.V = P + 1536 + h * 64; a.ldv = LDP;
                        a.O = O + 512 + h * 64; a.ldo = 1024; a.qrow0 = MCTX + b * 4096 + qb * 256; a.seg0row = MTOK + b * 256; a.seg0n = 256; a.seg1row = MCTX + b * 4096 + rsmin * 64; a.seg1n = nb * 64;
                        a.scale_log2 = na_sc; a.rpb = AIN(20) + h * 465; a.r0 = r0; a.rsmin = rsmin;
                        attn_unit<64, 64, 8, 0, true>(lds, a, wid);
                    } else if (u < 1152) {
                        const int v = u - 1024, b = v >> 3, h = v & 7;
                        a.Q = QM + h * 96; a.ldq = 768; a.Ka = KV + h * 128; a.ldka = 1024; a.Kb = KR; a.ldkb = 32; a.V = KV + h * 128 + 64; a.ldv = 1024;
                        a.O = O + h * 64; a.ldo = 1024; a.qrow0 = b * 256; a.seg0row = b * 256; a.seg0n = 256; a.seg1row = 0; a.seg1n = 0;
                        a.scale_log2 = mla_sc; a.rope = 0; a.tpos0 = 0; a.cosT = cosM; a.sinT = sinM;
                        attn_unit<96, 64, 8, 1, false>(lds, a, wid);
                    } else {
                        const int v = u - 1152, b = v >> 3, h = v & 7;
                        a.Q = P + 512 + h * 64; a.ldq = LDP; a.Ka = P + 1024 + h * 64; a.ldka = LDP; a.Kb = a.Ka; a.ldkb = LDP; a.V = P + 1536 + h * 64; a.ldv = LDP;
                        a.O = O + 512 + h * 64; a.ldo = 1024; a.qrow0 = b * 256; a.seg0row = b * 256; a.seg0n = 256; a.seg1row = 0; a.seg1n = 0;
                        a.scale_log2 = na_sc;
                        attn_unit<64, 64, 8, 0, false>(lds, a, wid);
                    }
                }
            }
            xcd_barrier(xbar); PH_RELOAD; modl = modv + l * 5 * 6144;
        } else {
            {
                pg8::Gemm g{HO, (const bf16_t*)(ws + WS_WINC), MTOK, NINC, 1024, 1024, 1024};
                pg8::StaticOrder S; S.init(MTOK, NINC, G, bid, 1024);
                pg8::EpiInC E{P2, out + O_GV};
                if (DBG_GM & 4) pg8::gemm_phase<pg8::EpiInC, true>(lds, g, S, E, wid);
            }
            xcd_barrier(xbar); PH_RELOAD; modl = modv + l * 5 * 6144;
            int lane = lane0; asm volatile("" : "+v"(lane));
            for (int row = gw; row < MALL; row += NGW) {
                if (row < MTOK) {
                    const bf16_t* pr = P2 + (size_t)row * NINC;
#pragma unroll
                    for (int kvh = 0; kvh < 2; ++kvh) {
                        const float x1 = __uint_as_float((unsigned)pr[1024 + kvh * 128 + lane] << 16), x2 = __uint_as_float((unsigned)pr[1024 + kvh * 128 + 64 + lane] << 16);
                        const float ss = wave_sum(x1 * x1 + x2 * x2, lane);
                        const float rstd = 1.0f / sqrtf(ss * (1.0f / 128.0f) + RMS_EPS);
                        float k1 = x1 * rstd * AIN(24)[lane], k2 = x2 * rstd * AIN(24)[64 + lane];
                        if (row < MCTX) { out[O_GK + (size_t)row * 256 + kvh * 128 + lane] = k1; out[O_GK + (size_t)row * 256 + kvh * 128 + 64 + lane] = k2; }
                        else { const int t = (row - MCTX) & 4095; const float c = cosG[t * 64 + lane], s = sinG[t * 64 + lane];
                            const float n1 = k1 * c - k2 * s, n2 = k1 * s + k2 * c; k1 = n1; k2 = n2; }
                        KG[(size_t)row * 256 + kvh * 128 + lane] = (bf16_t)(cvtpk(k1, 0.f) & 0xffffu); KG[(size_t)row * 256 + kvh * 128 + 64 + lane] = (bf16_t)(cvtpk(k2, 0.f) & 0xffffu);
                    }
                    *(u32x2*)(VG + (size_t)row * 256 + 4 * lane) = *(const u32x2*)(pr + 1280 + 4 * lane);
                } else {
                    const int j = row - MTOK;
                    const f32x4 kk = *(const f32x4*)(AIN(6) + (size_t)j * 256 + 4 * lane), vv = *(const f32x4*)(AIN(7) + (size_t)j * 256 + 4 * lane);
                    u32x2 w; w.x = cvtpk(kk[0], kk[1]); w.y = cvtpk(kk[2], kk[3]); *(u32x2*)(KG + (size_t)row * 256 + 4 * lane) = w;
                    w.x = cvtpk(vv[0], vv[1]); w.y = cvtpk(vv[2], vv[3]); *(u32x2*)(VG + (size_t)row * 256 + 4 * lane) = w;
                }
            }
            xcd_barrier(xbar); PH_RELOAD; modl = modv + l * 5 * 6144;
            {
                bf16_t* O = HO;
                const float sc = 0.08838834764831845f * LOG2E;
                int bidl = bid; asm volatile("" : "+s"(bidl));
                const bool xmap = (G == 256);
                for (int u = bidl; u < 640; u += G) {
                    AttnArgs a{};
                    int h;
                    if (u < 512) { const int v = (bidl >> 3) + 32 * (u >> 8), b = xmap ? ((bidl & 7) >> 1) : (u >> 7), qb = xmap ? (v & 15) : (u & 15); h = xmap ? ((bidl & 1) * 4 + (v >> 4)) : ((u >> 4) & 7);
                        a.qrow0 = MCTX + b * 4096 + qb * 256; a.seg0row = MCTX + b * 4096; a.seg0n = 4096; a.seg1row = MTOK + b * 256; a.seg1n = 256; a.rope = 1; a.tpos0 = qb * 256;
                    } else { const int v = u - 512, b = v >> 3; h = v & 7;
                        a.qrow0 = b * 256; a.seg0row = b * 256; a.seg0n = 256; a.seg1row = 0; a.seg1n = 0; a.rope = 0; a.tpos0 = 0; }
                    a.Q = P2 + h * 128; a.ldq = NINC; a.Ka = KG + (h >> 2) * 128; a.ldka = 256; a.Kb = a.Ka; a.ldkb = 256; a.V = VG + (h >> 2) * 128; a.ldv = 256;
                    a.O = O + h * 128; a.ldo = 1024; a.scale_log2 = sc; a.cosT = cosG; a.sinT = sinG; a.qnorm = AIN(23);
                    attn_unit<128, 128, 16, 2, false>(lds, a, wid);
                }
            }
            xcd_barrier(xbar); PH_RELOAD; modl = modv + l * 5 * 6144;
        }
        {
            pg8::Gemm g{HO, (const bf16_t*)(ws + (l == 0 ? WS_WOUTA : WS_WOUTC)), MTOK, 1024, 1024, 1024, 1024};
            pg8::StaticOrder S; S.init(MTOK, 1024, G, bid, 1024, (G == 256) ? 1 : 0);
            pg8::EpiRes E{l == 0 ? x_prompt : out, l == 0 ? x_sample : out + (size_t)MCTX * D, out, modl + 2 * 1024, (bf16_t*)(ws + WS_PART)};
            if (DBG_GM & 8) pg8::gemm_phase<pg8::EpiRes, true>(lds, g, S, E, wid);
        }
        xcd_barrier(xbar); PH_RELOAD; modl = modv + l * 5 * 6144;
        norm_mod_rows(out, out + (size_t)MCTX * D, AIN(13) + l * 1024, modl, 3, 4, HO, gw, NGW, lane0, (G == 256) ? (const bf16_t*)(ws + WS_PART) : nullptr, out, (l == 0 && G == 256) ? x_sample + (size_t)(16384 - MCTX) * D : nullptr);
        if (l == 0) {
            int tb = 0;
            tjob(AIN(22), 1024, NINC, (bf16_t*)(ws + WS_WINC), 0, tb, lds, gw, NGW, wid, lane0);
            tjob(AIN(25), 1024, 1024, (bf16_t*)(ws + WS_WOUTC), 0, tb, lds, gw, NGW, wid, lane0);
            tjob(AIN(26) + (size_t)1024 * 2 * DFF, 1024, 2 * DFF, (bf16_t*)(ws + WS_WF1_1), 2, tb, lds, gw, NGW, wid, lane0);
            tjob(AIN(27) + (size_t)DFF * 1024, DFF, 1024, (bf16_t*)(ws + WS_WF2_1), 0, tb, lds, gw, NGW, wid, lane0);
        }
        xcd_barrier(xbar); PH_RELOAD; modl = modv + l * 5 * 6144;
        {
            pg8::Gemm g{HO, (const bf16_t*)(ws + (l == 0 ? WS_WF1_0 : WS_WF1_1)), MTOK, 2 * DFF, 1024, 1024, 1024};
            pg8::StaticOrder S; S.init(MTOK, 2 * DFF, G, bid, 1024);
            pg8::EpiSwiglu E{HF};
            if (DBG_GM & 16) pg8::gemm_phase<pg8::EpiSwiglu, true>(lds, g, S, E, wid);
        }
        xcd_barrier(xbar); PH_RELOAD; modl = modv + l * 5 * 6144;
        {
            pg8::Gemm g{HF, (const bf16_t*)(ws + (l == 0 ? WS_WF2_0 : WS_WF2_1)), MTOK, 1024, DFF, DFF, DFF};
            pg8::StaticOrder S; S.init(MTOK, 1024, G, bid, DFF, (G == 256) ? 1 : 0);
            pg8::EpiRes E{out, out + (size_t)MCTX * D, out, modl + 5 * 1024, (bf16_t*)(ws + WS_PART)};
            if (DBG_GM & 32) pg8::gemm_phase<pg8::EpiRes, true>(lds, g, S, E, wid);
        }
        xcd_barrier(xbar); PH_RELOAD; modl = modv + l * 5 * 6144;
    }
    PH_RELOAD;
    int lane = lane0; asm volatile("" : "+v"(lane));
    for (int row = gw; row < MTOK; row += NGW) {
        float* xr = out + (size_t)row * D;
        f32x4 v[4]; float s = 0.f;
#pragma unroll
        for (int j = 0; j < 4; ++j) v[j] = *(const f32x4*)(xr + 4 * lane + 256 * j);
        if (G == 256 && row >= 16384) {
            const bf16_t* part = (const bf16_t*)(ws + WS_PART);
#pragma unroll
            for (int p = 0; p < 4; ++p)
#pragma unroll
                for (int j = 0; j < 4; ++j) { const u32x2 w = *(const u32x2*)(part + ((size_t)p * 4096 + (row - 16384)) * 1024 + 4 * lane + 256 * j);
                    v[j][0] += bf_lo(w.x); v[j][1] += bf_hi(w.x); v[j][2] += bf_lo(w.y); v[j][3] += bf_hi(w.y); }
        }
#pragma unroll
        for (int j = 0; j < 4; ++j) s += v[j][0] * v[j][0] + v[j][1] * v[j][1] + v[j][2] * v[j][2] + v[j][3] * v[j][3];
        const float rstd = 1.0f / sqrtf(wave_sum(s, lane) * (1.0f / D) + RMS_EPS);
#pragma unroll
        for (int j = 0; j < 4; ++j) { const f32x4 gg = *(const f32x4*)(AIN(14) + 4 * lane + 256 * j); *(f32x4*)(xr + 4 * lane + 256 * j) = v[j] * rstd * gg; }
    }
}

extern "C" void kernel_launch(void* const* d_in, const int* in_sizes, int n_in, void* d_out, int out_size, void* d_ws, size_t ws_size, hipStream_t stream) {
    static int grid_blocks = 0;
    if (grid_blocks == 0) {
        if (n_in != 28 || ws_size < WS_END0) { fprintf(stderr, "kernel_launch: unexpected n_in %d / ws_size %zu\n", n_in, ws_size); grid_blocks = -1; return; }
        int dev = 0, cus = 0, per_cu = 0;
        hipGetDevice(&dev);
        hipDeviceGetAttribute(&cus, hipDeviceAttributeMultiprocessorCount, dev);
        hipFuncSetAttribute((const void*)fwd_kernel, hipFuncAttributeMaxDynamicSharedMemorySize, LDS_BYTES);
        hipOccupancyMaxActiveBlocksPerMultiprocessor(&per_cu, (const void*)fwd_kernel, 512, LDS_BYTES);
        (void)hipGetLastError();
        if (per_cu < 1) per_cu = 1;
        grid_blocks = cus * 1;
        if (grid_blocks > 256) grid_blocks = 256;
    }
    if (grid_blocks < 0) return;
    if (hipMemsetAsync((char*)d_ws + WS_BAR, 0, XCD_BAR_WORDS * 4, stream) != hipSuccess) { fprintf(stderr, "kernel_launch: memset of barrier words failed\n"); return; }
    KArgs a{};
    for (int i = 0; i < 28; ++i) a.in[i] = (const float*)d_in[i];
    a.out = (float*)d_out; a.ws = (unsigned char*)d_ws;
    void* kargs[] = {&a};
    hipError_t e = hipLaunchCooperativeKernel((const void*)fwd_kernel, dim3(grid_blocks), dim3(512), kargs, LDS_BYTES, stream);
    if (e != hipSuccess) fprintf(stderr, "cooperative launch failed: %s (grid %d)\n", hipGetErrorString(e), grid_blocks);
}
```

```cpp
#include <hip/hip_runtime.h>
#include <hip/hip_cooperative_groups.h>
#include <cstdint>
#include <cstdio>
namespace cg = cooperative_groups;

#define LAS __attribute__((address_space(3)))
typedef unsigned short bf16_t;
typedef short bf16x8 __attribute__((ext_vector_type(8)));
typedef short s16x4 __attribute__((ext_vector_type(4)));
typedef float f32x4 __attribute__((ext_vector_type(4)));
typedef float f32x16 __attribute__((ext_vector_type(16)));
typedef unsigned u32x4 __attribute__((ext_vector_type(4)));
typedef unsigned u32x2 __attribute__((ext_vector_type(2)));
typedef float f32x2_t __attribute__((ext_vector_type(2)));
typedef __bf16 bf16x2_t __attribute__((ext_vector_type(2)));

__device__ __forceinline__ unsigned cvtpk(float lo, float hi) { f32x2_t v = {lo, hi}; bf16x2_t b = __builtin_convertvector(v, bf16x2_t); return __builtin_bit_cast(unsigned, b); }
__device__ __forceinline__ float bf_lo(unsigned u) { return __uint_as_float(u << 16); }
__device__ __forceinline__ float bf_hi(unsigned u) { return __uint_as_float(u & 0xffff0000u); }
__device__ __forceinline__ int lane_now() { int r; asm volatile("v_mbcnt_lo_u32_b32 %0, -1, 0\n\tv_mbcnt_hi_u32_b32 %0, -1, %0" : "=v"(r)); return r; }
__device__ __forceinline__ float wave_sum(float v, int lane) {
#pragma unroll
    for (int o = 32; o >= 1; o >>= 1) v += __builtin_bit_cast(float, __builtin_amdgcn_ds_bpermute((lane ^ o) << 2, __builtin_bit_cast(int, v)));
    return v;
}
__device__ __forceinline__ float half_sum(float v) { auto r = __builtin_amdgcn_permlane32_swap(__float_as_uint(v), __float_as_uint(v), false, false); return __uint_as_float(r[0]) + __uint_as_float(r[1]); }
__device__ __forceinline__ float half_max(float v) { auto r = __builtin_amdgcn_permlane32_swap(__float_as_uint(v), __float_as_uint(v), false, false); return fmaxf(__uint_as_float(r[0]), __uint_as_float(r[1])); }

constexpr int D = 1024, MCTX = 4096, MLAT = 16384, MTOK = 20480, MALL = 21504;
constexpr int DFF = 2816, NINA = 2304, LDP = 2304, NINC = 1536;
constexpr float RMS_EPS = 1e-6f;
constexpr float LOG2E = 1.4426950408889634f;
constexpr size_t MiB = 1u << 20;
constexpr size_t WS_MOD = 0;
constexpr size_t WS_BAR = 512 * 1024;
constexpr size_t WS_COSM = 1 * MiB, WS_SINM = 1 * MiB + 262144, WS_COSG = 2 * MiB, WS_SING = 3 * MiB;
constexpr size_t WS_WINA = 4 * MiB;
constexpr size_t WS_WUQ = WS_WINA + 4718592;
constexpr size_t WS_WUKV = WS_WUQ + 393216;
constexpr size_t WS_WOUTA = WS_WUKV + 524288;
constexpr size_t WS_WF1_0 = WS_WOUTA + 2097152;
constexpr size_t WS_WF2_0 = WS_WF1_0 + 11534336;
constexpr size_t WS_HO = 28 * MiB;
constexpr size_t WS_BIG = 68 * MiB;
constexpr size_t WS_P = WS_BIG;
constexpr size_t WS_QM = WS_P + 99090432;
constexpr size_t WS_KV = WS_QM + 31457280;
constexpr size_t WS_KR = WS_KV + 44040192;
constexpr size_t WS_END0 = WS_KR + 1376256;
constexpr size_t WS_HF = WS_BIG;
constexpr size_t WS_W1 = WS_BIG + 112 * MiB;
constexpr size_t WS_WINC = WS_W1;
constexpr size_t WS_WOUTC = WS_WINC + 3145728;
constexpr size_t WS_WF1_1 = WS_WOUTC + 2097152;
constexpr size_t WS_WF2_1 = WS_WF1_1 + 11534336;
constexpr size_t WS_PART = WS_BIG + 134 * MiB;
constexpr size_t WS_P2 = WS_BIG;
constexpr size_t WS_KG = WS_BIG + 60 * MiB;
constexpr size_t WS_VG = WS_KG + 11010048;
static_assert(WS_WF2_0 + 5767168 <= WS_HO, "w0");
static_assert(WS_END0 <= 256 * MiB, "ws");
static_assert(WS_WF2_1 + 5767168 <= WS_PART && WS_PART + 33554432 <= WS_END0, "w1/part");
constexpr size_t O_Y = 0, O_CKV = 20971520, O_KROPE = 22020096, O_NAK = 22151168, O_NAV = 24248320, O_GK = 26345472, O_GV = 27394048;

constexpr int LDS_BYTES = 147456;
#ifndef DBG_GM
#define DBG_GM 0xff
#endif

namespace pg8 {
constexpr int BM = 256, BK = 64, HALF = 128, HTB = HALF * BK * 2, STAGE_BYTES = 8 * HTB, NXCD = 8, WGM = 8;
__host__ __device__ __forceinline__ int lds_byte(int r, int c) { const int st = (r >> 4) * 2 + (c >> 5), rr = r & 15, cc = c & 31, ob = rr * 64 + cc * 2; return st * 1024 + (ob ^ (((ob >> 9) & 1) << 5)); }
__host__ __device__ __forceinline__ void stage_rc(int b, int& R, int& C) { const int st = b / 1024, sb = b % 1024, swz = sb ^ (((sb >> 9) & 1) << 5); R = (st >> 1) * 16 + swz / 64; C = (st & 1) * 32 + (swz % 64) / 2; }
__host__ __device__ __forceinline__ int perm32(int rho) { const int n = rho >> 4, i = rho & 15; return 8 * (i >> 2) + 4 * n + (i & 3); }
struct Unit { int pm, pn, k0, nt, part; };
struct Gemm { const bf16_t* A; const bf16_t* Bt; int M, N, K, lda, ldb; };
struct StaticOrder {
    int nM, nN, nwg, G, c, K, hybrid;
    __device__ void init(int M, int N, int G_, int c_, int K_ = 0, int hybrid_ = 0) { nM = hybrid_ ? 64 : M / BM; nN = N / BM; nwg = nM * nN; G = G_; c = c_; K = K_; hybrid = hybrid_; }
    __device__ bool next(int i, Unit& u) const {
        long L = (long)i * G + c; u.k0 = 0; u.nt = K / BK; u.part = 0;
        if (hybrid) {
            if (i > 1) return false;
            const int role = ((c >> 3) & 1) ? (1 - i) : i;
            if (role == 0) L = c;
            if (role == 1) { const int p = c >> 6; u.part = 1 + p; u.pm = 64 + ((c & 63) >> 2); u.pn = c & 3;
                if (K == 1024) { u.nt = 4; u.k0 = 256 * p; } else { u.nt = (p < 2) ? 12 : 10; u.k0 = (p < 2) ? 768 * p : 1536 + 640 * (p - 2); }
                return true; }
        }
        if (L >= nwg) return false;
        int wgid = (int)L; { const int q = nwg / NXCD, r = nwg % NXCD, xcd = wgid % NXCD, off = wgid / NXCD; wgid = (xcd < r ? xcd * (q + 1) : r * (q + 1) + (xcd - r) * q) + off; }
        const int nig = WGM * nN, gid = wgid / nig, fm = gid * WGM, gsz = (nM - fm) < WGM ? (nM - fm) : WGM;
        u.pm = fm + ((wgid % nig) % gsz); u.pn = (wgid % nig) / gsz; return true;
    }
};
template <class Epi, bool ALIGN_EPI>
__device__ __forceinline__ void gemm_phase(LAS unsigned char* lds, const Gemm g, const StaticOrder& S, const Epi& E, const int wid_in) {
    int tid_ = wid_in * 64 + lane_now(); asm volatile("" : "+v"(tid_));
    const int tid = tid_, wid = __builtin_amdgcn_readfirstlane(tid >> 6), lane = tid & 63, wr = wid >> 2, wc = wid & 3, fr = lane & 15, fq = lane >> 4;
    unsigned voffA[2], voffB[2];
#pragma unroll
    for (int i = 0; i < 2; ++i) { int R, C; stage_rc(tid * 16 + i * 8192, R, C); const int Rb = (R & ~31) + perm32(R & 31);
        voffA[i] = (unsigned)(R * g.lda + C) * 2u; voffB[i] = (unsigned)(Rb * g.ldb + C) * 2u; }
    const size_t kstep = (size_t)(BK * 2);
    const size_t hA = (size_t)HALF * g.lda * 2, hB = (size_t)HALF * g.ldb * 2, tA = 2 * hA, tB = 2 * hB;
    const unsigned ldsw = (unsigned)wid * 1024u;
    const int aoff = lds_byte(wr * 64 + fr, fq * 8), boff = lds_byte(wc * 32 + fr, fq * 8);
#define PG8_SA(b, h) (((b) * 2 + (h)) * HTB)
#define PG8_SB(b, h) ((4 + (b) * 2 + (h)) * HTB)
#define PG8_STAGE(bufoff, gbase, voff) do { _Pragma("unroll") for (int _i = 0; _i < 2; ++_i) \
        __builtin_amdgcn_global_load_lds((const unsigned*)((const char*)(gbase) + (voff)[_i]), (LAS unsigned*)(lds + (bufoff) + ldsw + _i * 8192), 16, 0, 0); } while (0)
#define PG8_LDA(dst, b, h) do { _Pragma("unroll") for (int m = 0; m < 4; ++m) _Pragma("unroll") for (int k = 0; k < 2; ++k) dst[m][k] = *(const LAS bf16x8*)(lds + PG8_SA(b, h) + aoff + m * 2048 + k * 1024); } while (0)
#define PG8_LDB(dst, b, h) do { _Pragma("unroll") for (int n = 0; n < 2; ++n) _Pragma("unroll") for (int k = 0; k < 2; ++k) dst[n][k] = *(const LAS bf16x8*)(lds + PG8_SB(b, h) + boff + n * 2048 + k * 1024); } while (0)
#define PG8_MMA(ai, bj, At, Bt) do { __builtin_amdgcn_s_setprio(1); _Pragma("unroll") for (int m = 0; m < 4; ++m) _Pragma("unroll") for (int n = 0; n < 2; ++n) _Pragma("unroll") for (int k = 0; k < 2; ++k) \
        acc[ai][bj][m][n] = __builtin_amdgcn_mfma_f32_16x16x32_bf16(Bt[n][k], At[m][k], acc[ai][bj][m][n], 0, 0, 0); __builtin_amdgcn_s_setprio(0); } while (0)
#define PG8_WAIT_V(n) asm volatile("s_waitcnt vmcnt(" #n ")" ::: "memory")
#define PG8_WAIT_L(n) asm volatile("s_waitcnt lgkmcnt(" #n ")" ::: "memory")
#define PG8_BAR __builtin_amdgcn_s_barrier()
#define PG8_SCHED __builtin_amdgcn_sched_barrier(0)
    Unit cur, nxt; int ui = 0;
#ifdef DBG_NOGEMM
    return;
#endif
    if (!S.next(0, cur)) return;
    f32x4 acc[2][2][4][2];
#pragma unroll
    for (int a = 0; a < 2; ++a)
#pragma unroll
        for (int b = 0; b < 2; ++b)
#pragma unroll
            for (int m = 0; m < 4; ++m)
#pragma unroll
                for (int n = 0; n < 2; ++n) acc[a][b][m][n] = (f32x4){0.f, 0.f, 0.f, 0.f};
    bf16x8 At[4][2], B0[2][2], B1[2][2];
    const char* cA = (const char*)g.A + (size_t)cur.pm * tA + (size_t)cur.k0 * 2; const char* cB = (const char*)g.Bt + (size_t)cur.pn * tB + (size_t)cur.k0 * 2;
    PG8_STAGE(PG8_SB(0, 0), cB, voffB); PG8_STAGE(PG8_SB(0, 1), cB + hB, voffB); PG8_STAGE(PG8_SA(0, 0), cA, voffA); PG8_STAGE(PG8_SA(0, 1), cA + hA, voffA);
    if (wr == 1) PG8_BAR;
    PG8_WAIT_V(2); PG8_BAR;
    PG8_STAGE(PG8_SB(1, 0), cB + kstep, voffB); PG8_STAGE(PG8_SA(1, 0), cA + kstep, voffA); PG8_STAGE(PG8_SB(1, 1), cB + hB + kstep, voffB);
    PG8_WAIT_V(6); PG8_BAR;
    for (;;) {
        const bool has_next = S.next(ui + 1, nxt);
        const char* nA = has_next ? (const char*)g.A + (size_t)nxt.pm * tA + (size_t)nxt.k0 * 2 : cA; const char* nB = has_next ? (const char*)g.Bt + (size_t)nxt.pn * tB + (size_t)nxt.k0 * 2 : cB;
        const int nt = cur.nt;
#pragma unroll 1
        for (int t = 0; t < nt; t += 2) {
            const bool last = (t == nt - 2);
            const char* a1 = cA + (size_t)(t + 1) * kstep;
            const char* a2 = last ? nA : cA + (size_t)(t + 2) * kstep; const char* b2 = last ? nB : cB + (size_t)(t + 2) * kstep;
            const char* a3 = a2 + kstep; const char* b3 = b2 + kstep;
            PG8_LDB(B0, 0, 0); PG8_LDB(B1, 0, 1); PG8_SCHED; PG8_LDA(At, 0, 0); PG8_STAGE(PG8_SA(1, 1), a1 + hA, voffA);
            PG8_WAIT_V(8); PG8_WAIT_L(0); PG8_BAR; PG8_MMA(0, 0, At, B0); PG8_MMA(0, 1, At, B1); PG8_BAR; PG8_SCHED;
            PG8_LDA(At, 0, 1); PG8_STAGE(PG8_SB(0, 0), b2, voffB); PG8_STAGE(PG8_SB(0, 1), b2 + hB, voffB); PG8_STAGE(PG8_SA(0, 0), a2, voffA);
            PG8_WAIT_V(8); PG8_WAIT_L(0); PG8_BAR; PG8_MMA(1, 0, At, B0); PG8_MMA(1, 1, At, B1); PG8_BAR; PG8_SCHED;
            PG8_LDB(B0, 1, 0); PG8_LDB(B1, 1, 1); PG8_SCHED; PG8_LDA(At, 1, 0); PG8_STAGE(PG8_SA(0, 1), a2 + hA, voffA);
            PG8_WAIT_V(8); PG8_WAIT_L(0); PG8_BAR; PG8_MMA(0, 0, At, B0); PG8_MMA(0, 1, At, B1); PG8_BAR; PG8_SCHED;
            PG8_LDA(At, 1, 1); PG8_STAGE(PG8_SB(1, 0), b3, voffB); PG8_STAGE(PG8_SB(1, 1), b3 + hB, voffB); PG8_STAGE(PG8_SA(1, 0), a3, voffA);
            PG8_WAIT_V(8); PG8_WAIT_L(0); PG8_BAR; PG8_MMA(1, 0, At, B0); PG8_MMA(1, 1, At, B1); PG8_BAR; PG8_SCHED;
        }
        if constexpr (ALIGN_EPI) { if (wr == 0) PG8_BAR; }
        E(acc, cur, wr, wc, fr, fq);
        if (!has_next) break;
#pragma unroll
        for (int a = 0; a < 2; ++a)
#pragma unroll
            for (int b = 0; b < 2; ++b)
#pragma unroll
                for (int m = 0; m < 4; ++m)
#pragma unroll
                    for (int n = 0; n < 2; ++n) acc[a][b][m][n] = (f32x4){0.f, 0.f, 0.f, 0.f};
        cur = nxt; cA = nA; cB = nB; ++ui;
        if constexpr (ALIGN_EPI) { if (wr == 1) PG8_BAR; }
    }
    PG8_WAIT_V(0);
    if constexpr (!ALIGN_EPI) { if (wr == 0) PG8_BAR; }
    PG8_BAR;
#undef PG8_SA
#undef PG8_SB
#undef PG8_STAGE
#undef PG8_LDA
#undef PG8_LDB
#undef PG8_MMA
#undef PG8_WAIT_V
#undef PG8_WAIT_L
#undef PG8_BAR
#undef PG8_SCHED
}

typedef f32x4 AccT[2][2][4][2];
__device__ __forceinline__ u32x4 pack8(const f32x4 v0, const f32x4 v1) { u32x4 w; w.x = cvtpk(v0[0], v0[1]); w.y = cvtpk(v0[2], v0[3]); w.z = cvtpk(v1[0], v1[1]); w.w = cvtpk(v1[2], v1[3]); return w; }

struct EpiStore {
    bf16_t* O; int ldc;
    __device__ __forceinline__ void operator()(const AccT& acc, const Unit& u, int wr, int wc, int fr, int fq) const {
        const int row0 = u.pm * BM + wr * 64 + fr, col0 = u.pn * BM + wc * 32 + 8 * fq;
#pragma unroll
        for (int ai = 0; ai < 2; ++ai)
#pragma unroll
            for (int m = 0; m < 4; ++m) { bf16_t* rowp = O + (size_t)(row0 + ai * HALF + m * 16) * ldc + col0;
#pragma unroll
                for (int bj = 0; bj < 2; ++bj) *(u32x4*)(rowp + bj * HALF) = pack8(acc[ai][bj][m][0], acc[ai][bj][m][1]); }
    }
};
struct EpiInA {
    bf16_t* P; float* st_nk; float* st_nv; float* st_kr;
    __device__ __forceinline__ void operator()(const AccT& acc, const Unit& u, int wr, int wc, int fr, int fq) const {
        const int row0 = u.pm * BM + wr * 64 + fr, pn = u.pn, col0 = pn * BM + wc * 32 + 8 * fq;
        const bool ctx = u.pm < 16;
#pragma unroll
        for (int ai = 0; ai < 2; ++ai)
#pragma unroll
            for (int m = 0; m < 4; ++m) { const int row = row0 + ai * HALF + m * 16;
#pragma unroll
                for (int bj = 0; bj < 2; ++bj) {
                    if (pn == 8 && (bj != 0 || wc != 0)) continue;
                    const int col = col0 + bj * HALF; const f32x4 v0 = acc[ai][bj][m][0], v1 = acc[ai][bj][m][1];
                    *(u32x4*)(P + (size_t)row * LDP + col) = pack8(v0, v1);
                    if (ctx) {
                        float* d = nullptr;
                        if (pn == 4 || pn == 5) d = st_nk + (size_t)row * 512 + (col - 1024);
                        else if (pn == 6 || pn == 7) d = st_nv + (size_t)row * 512 + (col - 1536);
                        else if (pn == 8) d = st_kr + (size_t)row * 32 + (col - 2048);
                        if (d) { *(f32x4*)d = v0; *(f32x4*)(d + 4) = v1; }
                    }
                } }
    }
};
struct EpiInC {
    bf16_t* P; float* st_gv;
    __device__ __forceinline__ void operator()(const AccT& acc, const Unit& u, int wr, int wc, int fr, int fq) const {
        const int row0 = u.pm * BM + wr * 64 + fr, pn = u.pn, col0 = pn * BM + wc * 32 + 8 * fq;
        const bool st = (u.pm < 16) && (pn == 5);
#pragma unroll
        for (int ai = 0; ai < 2; ++ai)
#pragma unroll
            for (int m = 0; m < 4; ++m) { const int row = row0 + ai * HALF + m * 16;
#pragma unroll
                for (int bj = 0; bj < 2; ++bj) {
                    const int col = col0 + bj * HALF; const f32x4 v0 = acc[ai][bj][m][0], v1 = acc[ai][bj][m][1];
                    *(u32x4*)(P + (size_t)row * NINC + col) = pack8(v0, v1);
                    if (st) { float* d = st_gv + (size_t)row * 256 + (col - 1280); *(f32x4*)d = v0; *(f32x4*)(d + 4) = v1; }
                } }
    }
};
struct EpiRes {
    const float* srcLo; const float* srcHi; float* dst; const float* gate; bf16_t* part;
    __device__ __forceinline__ void operator()(const AccT& acc, const Unit& u, int wr, int wc, int fr, int fq) const {
        const int row0 = u.pm * BM + wr * 64 + fr, col0 = u.pn * BM + wc * 32 + 8 * fq;
        const int grp = u.pm < 16 ? 4 : ((u.pm - 16) >> 4);
        const float* gp = gate + grp * 6144 + col0;
        f32x4 gv[2][2];
#pragma unroll
        for (int bj = 0; bj < 2; ++bj) { gv[bj][0] = *(const f32x4*)(gp + bj * HALF); gv[bj][1] = *(const f32x4*)(gp + bj * HALF + 4); }
        const float* src = (u.pm < 16) ? srcLo : (srcHi - (size_t)MCTX * D);
#pragma unroll
        for (int ai = 0; ai < 2; ++ai)
#pragma unroll
            for (int m = 0; m < 4; ++m) { const size_t off = (size_t)(row0 + ai * HALF + m * 16) * D + col0;
#pragma unroll
                for (int bj = 0; bj < 2; ++bj) {
                    if (u.part) {
                        bf16_t* d = part + (size_t)(u.part - 1) * 4096 * 1024 + (off - (size_t)16384 * D) + bj * HALF;
                        *(u32x4*)d = pack8(gv[bj][0] * acc[ai][bj][m][0], gv[bj][1] * acc[ai][bj][m][1]);
                    } else {
                    const f32x4 x0 = *(const f32x4*)(src + off + bj * HALF), x1 = *(const f32x4*)(src + off + bj * HALF + 4);
                    *(f32x4*)(dst + off + bj * HALF) = x0 + gv[bj][0] * acc[ai][bj][m][0];
                    *(f32x4*)(dst + off + bj * HALF + 4) = x1 + gv[bj][1] * acc[ai][bj][m][1];
                    }
                } }
    }
};
struct EpiSwiglu {
    bf16_t* HF;
    __device__ __forceinline__ void operator()(const AccT& acc, const Unit& u, int wr, int wc, int fr, int fq) const {
        const int row0 = u.pm * BM + wr * 64 + fr, col0 = u.pn * HALF + wc * 32 + 8 * fq;
#pragma unroll
        for (int ai = 0; ai < 2; ++ai)
#pragma unroll
            for (int m = 0; m < 4; ++m) {
                f32x4 h[2];
#pragma unroll
                for (int n = 0; n < 2; ++n) { const f32x4 gt = acc[ai][0][m][n], up = acc[ai][1][m][n];
#pragma unroll
                    for (int e = 0; e < 4; ++e) { const float s = __builtin_amdgcn_rcpf(1.0f + __builtin_amdgcn_exp2f(-gt[e] * LOG2E)); h[n][e] = gt[e] * s * up[e]; } }
                *(u32x4*)(HF + (size_t)(row0 + ai * HALF + m * 16) * DFF + col0) = pack8(h[0], h[1]);
            }
    }
};
}

struct AttnArgs {
    const bf16_t* Q; int ldq;
    const bf16_t* Ka; int ldka; const bf16_t* Kb; int ldkb; const bf16_t* V; int ldv;
    bf16_t* O; int ldo;
    int qrow0;
    int seg0row, seg0n, seg1row, seg1n;
    float scale_log2;
    int rope; int tpos0;
    const float* cosT; const float* sinT; const float* qnorm;
    const float* rpb; int r0, rsmin;
};
__device__ __forceinline__ void glds16(const void* gsrc, unsigned lds_dst) { unsigned keep;
    asm volatile("s_mov_b32 %0, m0\n\ts_mov_b32 m0, %2\n\ts_nop 0\n\tglobal_load_lds_dwordx4 %1, off\n\ts_mov_b32 m0, %0" : "=&s"(keep) : "v"(gsrc), "s"(lds_dst) : "memory"); }
__device__ __forceinline__ float max3f(float a, float b, float c) { float r; asm("v_max3_f32 %0, %1, %2, %3" : "=v"(r) : "v"(a), "v"(b), "v"(c)); return r; }
__device__ __forceinline__ float max2f(float a, float b) { float r; asm("v_max_f32_e32 %0, %1, %2" : "=v"(r) : "v"(a), "v"(b)); return r; }
__device__ __forceinline__ int crow(int r, int hi) { return (r & 3) + 8 * (r >> 2) + 4 * hi; }

template <int DQK, int DV, int KSPLIT, int QMODE  , bool NA>
__device__ __forceinline__ void attn_unit(LAS unsigned char* lds, const AttnArgs& a, const int wid_in) {
    constexpr int KROW = (DQK > 64) ? 256 : 128, VROW = DV * 2;
    constexpr int KBUF = 64 * KROW, VBUF = 64 * VROW;
    constexpr int NKD = KBUF / 8192, NVD = VBUF / 8192;
    constexpr int ND0 = DQK / 16, NDB = DV / 32;
    constexpr int OFF_K = 0, OFF_V = 4 * KBUF, OFF_RPB = 4 * KBUF + 3 * VBUF;
    int tid_ = wid_in * 64 + lane_now(); asm volatile("" : "+v"(tid_));
    const int tid = tid_, lane = tid & 63, r32 = lane & 31, hi = lane >> 5;
    const int wid = __builtin_amdgcn_readfirstlane(tid >> 6);
    const int n0t = a.seg0n >> 6, NT = n0t + (a.seg1n >> 6);

    const bf16_t* kp[NKD]; int kst[NKD]; const bf16_t* vp[NVD];
#pragma unroll
    for (int i = 0; i < NKD; ++i) {
        int row, c;
        if (KROW == 256) { row = 8 * wid + 4 * i + (lane >> 4); c = (lane & 15) ^ (row & 15); }
        else { row = 8 * wid + (lane >> 3); c = (lane & 7) ^ ((row >> 1) & 7); }
        if (c >= DQK / 8) c = 0;
        if (c < KSPLIT) { kp[i] = a.Ka + (size_t)row * a.ldka + c * 8; kst[i] = a.ldka; }
        else { kp[i] = a.Kb + (size_t)row * a.ldkb + (c - KSPLIT) * 8; kst[i] = a.ldkb; }
    }
#pragma unroll
    for (int i = 0; i < NVD; ++i) {
        int row, c;
        if (VROW == 256) { row = 8 * wid + 4 * i + (lane >> 4); c = (lane & 15) ^ (4 * (row & 3)); }
        else { row = 8 * wid + (lane >> 3); c = (lane & 7) ^ (4 * ((row >> 1) & 1)); }
        vp[i] = a.V + (size_t)row * a.ldv + c * 8;
    }
    const unsigned lds0 = (unsigned)(uintptr_t)lds;
    auto tile_rb = [&](int t) { t = t < NT ? t : NT - 1; return (t < n0t) ? (a.seg0row + 64 * t) : (a.seg1row + 64 * (t - n0t)); };
    auto issueK = [&](int t, int slot) {
        const int rb = tile_rb(t);
#pragma unroll
        for (int i = 0; i < NKD; ++i)
            glds16(kp[i] + (size_t)rb * kst[i], (unsigned)__builtin_amdgcn_readfirstlane((int)(lds0 + OFF_K + slot * KBUF + (wid * NKD + i) * 1024)));
    };
    auto issueV = [&](int t, int slot) {
        const int rb = tile_rb(t);
#pragma unroll
        for (int i = 0; i < NVD; ++i)
            glds16(vp[i] + (size_t)rb * a.ldv, (unsigned)__builtin_amdgcn_readfirstlane((int)(lds0 + OFF_V + slot * VBUF + (wid * NVD + i) * 1024)));
    };

    issueK(0, 0); issueV(0, 0); issueK(1, 1); issueV(1, 1); issueK(2, 2);
    if (NA) { for (int i = tid; i < 465; i += 512) *(LAS float*)(lds + OFF_RPB + i * 4) = a.rpb[i] * LOG2E; }

    const int qrow = a.qrow0 + wid * 32 + r32;
    bf16x8 qf[ND0];
    {
        const bf16_t* qp = a.Q + (size_t)qrow * a.ldq + hi * 8;
        u32x4 qraw[ND0];
#pragma unroll
        for (int d0 = 0; d0 < ND0; ++d0) qraw[d0] = *(const u32x4*)(qp + d0 * 16);
        if (QMODE == 1) {
            if (a.rope) {
                const int tpos = a.tpos0 + wid * 32 + r32;
                const float* cp = a.cosT + (size_t)tpos * 16 + hi * 8; const float* sp = a.sinT + (size_t)tpos * 16 + hi * 8;
                const f32x4 c0 = *(const f32x4*)cp, c1 = *(const f32x4*)(cp + 4), s0 = *(const f32x4*)sp, s1 = *(const f32x4*)(sp + 4);
                float cc[8] = {c0[0], c0[1], c0[2], c0[3], c1[0], c1[1], c1[2], c1[3]}, ss[8] = {s0[0], s0[1], s0[2], s0[3], s1[0], s1[1], s1[2], s1[3]};
                u32x4 y1, y2;
#pragma unroll
                for (int w = 0; w < 4; ++w) {
                    const float a0 = bf_lo(qraw[4][w]), a1 = bf_hi(qraw[4][w]), b0 = bf_lo(qraw[5][w]), b1 = bf_hi(qraw[5][w]);
                    y1[w] = cvtpk(a0 * cc[2 * w] - b0 * ss[2 * w], a1 * cc[2 * w + 1] - b1 * ss[2 * w + 1]);
                    y2[w] = cvtpk(a0 * ss[2 * w] + b0 * cc[2 * w], a1 * ss[2 * w + 1] + b1 * cc[2 * w + 1]);
                }
                qraw[4] = y1; qraw[5] = y2;
            }
        }
        if (QMODE == 2) {
            float ssq = 0.f;
#pragma unroll
            for (int d0 = 0; d0 < ND0; ++d0)
#pragma unroll
                for (int w = 0; w < 4; ++w) { const float x0 = bf_lo(qraw[d0][w]), x1 = bf_hi(qraw[d0][w]); ssq += x0 * x0 + x1 * x1; }
            ssq = half_sum(ssq);
            const float rstd = a.scale_log2 / sqrtf(ssq * (1.0f / 128.0f) + RMS_EPS);
            const int tpos = a.tpos0 + wid * 32 + r32;
#pragma unroll
            for (int d0 = 0; d0 < 4; ++d0) {
                const float* g1 = a.qnorm + 16 * d0 + 8 * hi; const float* g2 = g1 + 64;
                const float* cp = a.cosT + (size_t)tpos * 64 + 16 * d0 + 8 * hi; const float* sp = a.sinT + (size_t)tpos * 64 + 16 * d0 + 8 * hi;
                f32x4 cv[2] = {(f32x4){1.f, 1.f, 1.f, 1.f}, (f32x4){1.f, 1.f, 1.f, 1.f}}, sv[2] = {(f32x4){0.f, 0.f, 0.f, 0.f}, (f32x4){0.f, 0.f, 0.f, 0.f}};
                if (a.rope) { cv[0] = *(const f32x4*)cp; cv[1] = *(const f32x4*)(cp + 4); sv[0] = *(const f32x4*)sp; sv[1] = *(const f32x4*)(sp + 4); }
                u32x4 y1, y2;
#pragma unroll
                for (int w = 0; w < 4; ++w) {
                    float a0 = bf_lo(qraw[d0][w]) * rstd * g1[2 * w], a1 = bf_hi(qraw[d0][w]) * rstd * g1[2 * w + 1];
                    float b0 = bf_lo(qraw[d0 + 4][w]) * rstd * g2[2 * w], b1 = bf_hi(qraw[d0 + 4][w]) * rstd * g2[2 * w + 1];
                    if (a.rope) {
                        const float c0 = cv[w >> 1][(2 * w) & 3], c1 = cv[w >> 1][(2 * w + 1) & 3], s0 = sv[w >> 1][(2 * w) & 3], s1 = sv[w >> 1][(2 * w + 1) & 3];
                        const float n0 = a0 * c0 - b0 * s0, n1 = a1 * c1 - b1 * s1, m0 = a0 * s0 + b0 * c0, m1 = a1 * s1 + b1 * c1;
                        a0 = n0; a1 = n1; b0 = m0; b1 = m1;
                    }
                    y1[w] = cvtpk(a0, a1); y2[w] = cvtpk(b0, b1);
                }
                qraw[d0] = y1; qraw[d0 + 4] = y2;
            }
        }
        if (QMODE != 2) {
#pragma unroll
            for (int d0 = 0; d0 < ND0; ++d0)
#pragma unroll
                for (int w = 0; w < 4; ++w) qraw[d0][w] = cvtpk(bf_lo(qraw[d0][w]) * a.scale_log2, bf_hi(qraw[d0][w]) * a.scale_log2);
        }
#pragma unroll
        for (int d0 = 0; d0 < ND0; ++d0) qf[d0] = __builtin_bit_cast(bf16x8, qraw[d0]);
    }

    f32x16 o[NDB];
#pragma unroll
    for (int i = 0; i < NDB; ++i) o[i] = f32x16{};
    constexpr bool NEGC = (DV == 64);
    float m_run = NEGC ? 0.f : -1e30f, l_run = 0.f;
    f32x16 negm16 = f32x16{};

    const int qr = NA ? (a.r0 + (wid >> 1)) : 0;
    const int qc = NA ? ((wid & 1) * 32 + r32) : 0;
    const int rs = NA ? min(max(qr - 4, 0), 56) : 0;
    const int cs = NA ? min(max(qc - 8, 0), 48) : 0;

    const int ksw = (KROW == 256) ? (r32 & 15) : ((r32 >> 1) & 7);
    const int ke = hi ^ ksw;
    const LAS unsigned char* krow = lds + OFF_K + r32 * KROW;
    auto qk = [&](int slot, f32x16& p0, f32x16& p1, const f32x16& cinit) {
        const LAS unsigned char* kb = krow + slot * KBUF;
#pragma unroll
        for (int d0 = 0; d0 < ND0; ++d0) {
            const int co = ((2 * d0) ^ ke) * 16;
            const bf16x8 k0 = *(const LAS bf16x8*)(kb + co);
            const bf16x8 k1 = *(const LAS bf16x8*)(kb + 32 * KROW + co);
            p0 = __builtin_amdgcn_mfma_f32_32x32x16_bf16(k0, qf[d0], d0 == 0 ? cinit : p0, 0, 0, 0);
            p1 = __builtin_amdgcn_mfma_f32_32x32x16_bf16(k1, qf[d0], d0 == 0 ? cinit : p1, 0, 0, 0);
        }
    };
    const int q4 = (lane & 15) >> 2, pp = lane & 3, blk = (lane >> 4) & 1;
    const int vsw = (VROW == 256) ? q4 : ((q4 >> 1) & 1);
    const int vlane_off = (4 * hi + q4) * VROW + 32 * blk + 8 * pp;
    constexpr float THR = 8.0f;
#define ATT_WAIT_BAR(N) do { asm volatile("s_waitcnt vmcnt(%0) lgkmcnt(0)" :: "n"(N) : "memory"); __builtin_amdgcn_s_barrier(); asm volatile("" ::: "memory"); } while (0)

    ATT_WAIT_BAR(2 * NKD + 2 * NVD);
    f32x16 p0, p1, n0, n1;
    qk(0, p0, p1, negm16);
    auto na_skip = [&](int t) { if (!NA || t < n0t || t >= NT) return false; const int kr = a.rsmin + (t - n0t); return (kr < rs) || (kr >= rs + 8); };
    int ks1 = 1, ks3 = 3, vs0 = 0, vs2 = 2;
    auto step = [&](int t, f32x16& p0, f32x16& p1, f32x16& n0, f32x16& n1) {
        ATT_WAIT_BAR(NKD + NVD);
        issueK(t + 3, ks3); issueV(t + 2, vs2);
        constexpr int HA = ND0 / 2;
        bf16x8 kA0[HA], kA1[HA];
        const LAS unsigned char* kbn = krow + ks1 * KBUF;
        if (!NA) {
#pragma unroll
            for (int d0 = 0; d0 < HA; ++d0) { const int co = ((2 * d0) ^ ke) * 16; kA0[d0] = *(const LAS bf16x8*)(kbn + co); kA1[d0] = *(const LAS bf16x8*)(kbn + 32 * KROW + co); }
            __builtin_amdgcn_sched_barrier(0);
        }
        const bool skip = na_skip(t);
        if (!skip) {
            if (NA && t >= n0t) {
                const int kr = a.rsmin + (t - n0t);
                const LAS float* bt = (const LAS float*)(lds + OFF_RPB) + (kr - qr + 7) * 31;
#pragma unroll
                for (int r = 0; r < 16; ++r) {
                    const int kc0 = crow(r, hi), kc1 = kc0 + 32;
                    const bool v0 = (kc0 >= cs) && (kc0 < cs + 16), v1 = (kc1 >= cs) && (kc1 < cs + 16);
                    const int i0 = min(max(kc0 - qc + 15, 0), 30), i1 = min(max(kc1 - qc + 15, 0), 30);
                    const float b0 = bt[i0], b1 = bt[i1];
                    p0[r] = v0 ? (p0[r] + b0) : -1e30f;
                    p1[r] = v1 ? (p1[r] + b1) : -1e30f;
                }
            }
            float mx = max2f(p0[0], p1[0]), mx2 = max2f(p0[1], p1[1]);
#pragma unroll
            for (int r = 2; r < 16; r += 2) { mx = max3f(mx, p0[r], p1[r]); mx2 = max3f(mx2, p0[r + 1], p1[r + 1]); }
            mx = max2f(mx, mx2);
            mx = half_max(mx);
            float negm = 0.f;
            if (NEGC) {
                if (t == 0 || __any(mx > THR)) {
                    const float dl = (t == 0) ? mx : fmaxf(mx, 0.f);
                    m_run += dl;
#pragma unroll
                    for (int r = 0; r < 16; ++r) { p0[r] -= dl; p1[r] -= dl; }
                    if (t != 0) {
                        const float f = __builtin_amdgcn_exp2f(-dl);
                        l_run *= f;
#pragma unroll
                        for (int i = 0; i < NDB; ++i)
#pragma unroll
                            for (int r = 0; r < 16; ++r) o[i][r] *= f;
                    }
#pragma unroll
                    for (int r = 0; r < 16; ++r) negm16[r] = -m_run;
                }
            } else {
                if (__any(mx > m_run + THR)) {
                    const float m_new = max2f(m_run, mx);
                    const float alpha = __builtin_amdgcn_exp2f(m_run - m_new);
                    m_run = m_new; l_run *= alpha;
#pragma unroll
                    for (int i = 0; i < NDB; ++i)
#pragma unroll
                        for (int r = 0; r < 16; ++r) o[i][r] *= alpha;
                }
                negm = -m_run;
            }
            if (!NA) {
#pragma unroll
                for (int d0 = 0; d0 < HA; ++d0) {
                    n0 = __builtin_amdgcn_mfma_f32_32x32x16_bf16(kA0[d0], qf[d0], d0 == 0 ? negm16 : n0, 0, 0, 0);
                    n1 = __builtin_amdgcn_mfma_f32_32x32x16_bf16(kA1[d0], qf[d0], d0 == 0 ? negm16 : n1, 0, 0, 0);
                }
                bf16x8 kB0[ND0 - HA], kB1[ND0 - HA];
#pragma unroll
                for (int d0 = HA; d0 < ND0; ++d0) { const int co = ((2 * d0) ^ ke) * 16; kB0[d0 - HA] = *(const LAS bf16x8*)(kbn + co); kB1[d0 - HA] = *(const LAS bf16x8*)(kbn + 32 * KROW + co); }
#pragma unroll
                for (int d0 = HA; d0 < ND0; ++d0) {
                    n0 = __builtin_amdgcn_mfma_f32_32x32x16_bf16(kB0[d0 - HA], qf[d0], n0, 0, 0, 0);
                    n1 = __builtin_amdgcn_mfma_f32_32x32x16_bf16(kB1[d0 - HA], qf[d0], n1, 0, 0, 0);
                }
            } else {
                if (!na_skip(t + 1)) qk(ks1, n0, n1, negm16);
            }
            {
                f32x2_t sum2 = {0.f, 0.f};
#pragma unroll
                for (int r = 0; r < 16; r += 2) {
                    f32x2_t a2 = {p0[r], p0[r + 1]}, b2 = {p1[r], p1[r + 1]};
                    if (!NEGC) { const f32x2_t nm2 = {negm, negm}; a2 += nm2; b2 += nm2; }
                    a2.x = __builtin_amdgcn_exp2f(a2.x); a2.y = __builtin_amdgcn_exp2f(a2.y); b2.x = __builtin_amdgcn_exp2f(b2.x); b2.y = __builtin_amdgcn_exp2f(b2.y);
                    sum2 += a2; sum2 += b2;
                    p0[r] = a2.x; p0[r + 1] = a2.y; p1[r] = b2.x; p1[r + 1] = b2.y;
                }
                l_run += sum2.x + sum2.y;
            }
            bf16x8 pa[4];
            {
                u32x4 w;
                w.x = cvtpk(p0[0], p0[1]); w.y = cvtpk(p0[2], p0[3]); w.z = cvtpk(p0[4], p0[5]); w.w = cvtpk(p0[6], p0[7]); pa[0] = __builtin_bit_cast(bf16x8, w);
                w.x = cvtpk(p0[8], p0[9]); w.y = cvtpk(p0[10], p0[11]); w.z = cvtpk(p0[12], p0[13]); w.w = cvtpk(p0[14], p0[15]); pa[1] = __builtin_bit_cast(bf16x8, w);
                w.x = cvtpk(p1[0], p1[1]); w.y = cvtpk(p1[2], p1[3]); w.z = cvtpk(p1[4], p1[5]); w.w = cvtpk(p1[6], p1[7]); pa[2] = __builtin_bit_cast(bf16x8, w);
                w.x = cvtpk(p1[8], p1[9]); w.y = cvtpk(p1[10], p1[11]); w.z = cvtpk(p1[12], p1[13]); w.w = cvtpk(p1[14], p1[15]); pa[3] = __builtin_bit_cast(bf16x8, w);
            }
            const LAS unsigned char* vb = lds + OFF_V + vs0 * VBUF + vlane_off;
#pragma unroll
            for (int ks = 0; ks < 4; ++ks)
#pragma unroll
                for (int db = 0; db < NDB; ++db) {
                    const LAS unsigned char* vq = vb + (16 * ks) * VROW + ((db ^ vsw) * 64);
                    const s16x4 lo = __builtin_bit_cast(s16x4, __builtin_amdgcn_ds_read_tr16_b64_v4i16((LAS s16x4*)(vq)));
                    const s16x4 hh = __builtin_bit_cast(s16x4, __builtin_amdgcn_ds_read_tr16_b64_v4i16((LAS s16x4*)(vq + 8 * VROW)));
                    const bf16x8 vf = (bf16x8){lo[0], lo[1], lo[2], lo[3], hh[0], hh[1], hh[2], hh[3]};
                    o[db] = __builtin_amdgcn_mfma_f32_32x32x16_bf16(vf, pa[ks], o[db], 0, 0, 0);
                }
        } else { if (NA && !na_skip(t + 1)) qk(ks1, n0, n1, negm16); }
        ks1 = (ks1 + 1) & 3; ks3 = (ks3 + 1) & 3; vs0 = (vs0 == 2) ? 0 : vs0 + 1; vs2 = (vs2 == 2) ? 0 : vs2 + 1;
    };
    {
        int t = 0;
        for (; t + 1 < NT; t += 2) { step(t, p0, p1, n0, n1); step(t + 1, n0, n1, p0, p1); }
        if (t < NT) step(t, p0, p1, n0, n1);
    }
    const float lt = half_sum(l_run);
    const float inv = 1.0f / lt;
    ATT_WAIT_BAR(0);
    {
        constexpr int OP = DV * 2 + 8;
        int lane2 = lane; asm volatile("" : "+v"(lane2));
        const int e32 = lane2 & 31, ehi = lane2 >> 5;
        LAS unsigned char* stg = lds + wid * (32 * OP);
#pragma unroll
        for (int db = 0; db < NDB; ++db)
#pragma unroll
            for (int r4 = 0; r4 < 4; ++r4) {
                u32x2 w; w.x = cvtpk(o[db][4 * r4] * inv, o[db][4 * r4 + 1] * inv); w.y = cvtpk(o[db][4 * r4 + 2] * inv, o[db][4 * r4 + 3] * inv);
                *(LAS u32x2*)(stg + e32 * OP + (32 * db + 8 * r4 + 4 * ehi) * 2) = w;
            }
        constexpr int CH = DV / 8, RPI = 64 / CH;
        bf16_t* ob = a.O + (size_t)(a.qrow0 + wid * 32) * a.ldo;
#pragma unroll
        for (int i = 0; i < 32 / RPI; ++i) {
            const int row = i * RPI + lane2 / CH, ch = lane2 % CH;
            const u32x2 lo = *(const LAS u32x2*)(stg + row * OP + ch * 16), hh = *(const LAS u32x2*)(stg + row * OP + ch * 16 + 8);
            *(u32x4*)(ob + (size_t)row * a.ldo + ch * 8) = (u32x4){lo.x, lo.y, hh.x, hh.y};
        }
    }
    ATT_WAIT_BAR(0);
#undef ATT_WAIT_BAR
}

struct KArgs { const float* in[28]; float* out; unsigned char* ws; };

__device__ __forceinline__ void transpose_item(const float* W, int K, int N, bf16_t* WT, int mapmode, LAS float* scr, int item, int lane) {
    const int nblk = N / 32, kb = item / nblk, nb = item % nblk, k0 = 64 * kb, n0 = 32 * nb;
    int d0 = n0;
    if (mapmode == 1) {
        if (n0 < 512) d0 = n0; else if (n0 < 544) d0 = 2048 + (n0 - 512); else d0 = n0 - 32;
    } else if (mapmode == 2) {
        if (n0 < DFF) d0 = (n0 >> 7) * 256 + (n0 & 127); else { const int j = n0 - DFF; d0 = (j >> 7) * 256 + 128 + (j & 127); }
    }
#pragma unroll 8
    for (int i = 0; i < 32; ++i) { const int kk = 2 * i + (lane >> 5); scr[kk * 33 + (lane & 31)] = W[(size_t)(k0 + kk) * N + n0 + (lane & 31)]; }
    asm volatile("s_waitcnt lgkmcnt(0)" ::: "memory");
    const int c = lane & 7;
#pragma unroll
    for (int j = 0; j < 4; ++j) { const int n = (lane >> 3) + 8 * j; const LAS float* s = scr + (8 * c) * 33 + n;
        u32x4 o; o.x = cvtpk(s[0 * 33], s[1 * 33]); o.y = cvtpk(s[2 * 33], s[3 * 33]); o.z = cvtpk(s[4 * 33], s[5 * 33]); o.w = cvtpk(s[6 * 33], s[7 * 33]);
        *(u32x4*)(WT + (size_t)(d0 + n) * K + k0 + 8 * c) = o; }
    asm volatile("s_waitcnt lgkmcnt(0)" ::: "memory");
}

__device__ __forceinline__ void tjob(const float* W, int K, int N, bf16_t* WT, int map, int& base, LAS unsigned char* lds, int gw, int NGW, int wid, int lane) {
    asm volatile("" : "+v"(lane));
    LAS float* scr = (LAS float*)(lds + wid * 16384);
    const int items = (K / 64) * (N / 32);
    const int first = ((gw - base) % NGW + NGW) % NGW;
    for (int it = first; it < items; it += NGW) transpose_item(W, K, N, WT, map, scr, it, lane);
    base += items;
}

__device__ __forceinline__ void norm_mod_rows(const float* srcLo, const float* srcHi, const float* g, const float* modl, int shi, int sci, bf16_t* H, int gw, int NGW, int lane_in, const bf16_t* part = nullptr, float* xwb = nullptr, const float* srcSplit = nullptr) {
    int lane = lane_in; asm volatile("" : "+v"(lane));
    for (int row0 = gw; row0 < MTOK; row0 += 2 * NGW) {
        f32x4 v[2][4]; int rows[2]; bool ok[2];
#pragma unroll
        for (int q = 0; q < 2; ++q) {
            const int row = row0 + q * NGW; rows[q] = row; ok[q] = row < MTOK;
            if (ok[q]) { const float* xr = (row < MCTX) ? srcLo + (size_t)row * D : srcHi + (size_t)(row - MCTX) * D;
                if (srcSplit != nullptr && row >= 16384) xr = srcSplit + (size_t)(row - 16384) * D;
#pragma unroll
                for (int j = 0; j < 4; ++j) v[q][j] = *(const f32x4*)(xr + 4 * lane + 256 * j); }
        }
#pragma unroll
        for (int q = 0; q < 2; ++q) {
            if (!ok[q]) continue;
            const int row = rows[q];
            if (part != nullptr && row >= 16384) {
#pragma unroll
                for (int p = 0; p < 4; ++p)
#pragma unroll
                    for (int j = 0; j < 4; ++j) { const u32x2 w = *(const u32x2*)(part + ((size_t)p * 4096 + (row - 16384)) * 1024 + 4 * lane + 256 * j);
                        v[q][j][0] += bf_lo(w.x); v[q][j][1] += bf_hi(w.x); v[q][j][2] += bf_lo(w.y); v[q][j][3] += bf_hi(w.y); }
#pragma unroll
                for (int j = 0; j < 4; ++j) *(f32x4*)(xwb + (size_t)row * D + 4 * lane + 256 * j) = v[q][j];
            }
            const int grp = row < MCTX ? 4 : ((row - MCTX) >> 12);
            const float* sh = modl + grp * 6144 + shi * 1024; const float* sc = modl + grp * 6144 + sci * 1024;
            float s = 0.f;
#pragma unroll
            for (int j = 0; j < 4; ++j) s += v[q][j][0] * v[q][j][0] + v[q][j][1] * v[q][j][1] + v[q][j][2] * v[q][j][2] + v[q][j][3] * v[q][j][3];
            const float rstd = 1.0f / sqrtf(wave_sum(s, lane) * (1.0f / D) + RMS_EPS);
#pragma unroll
            for (int j = 0; j < 4; ++j) {
                const int c = 4 * lane + 256 * j;
                const f32x4 gg = *(const f32x4*)(g + c), s1 = *(const f32x4*)(sc + c), s0 = *(const f32x4*)(sh + c);
                f32x4 y;
#pragma unroll
                for (int e = 0; e < 4; ++e) y[e] = v[q][j][e] * rstd * gg[e] * (1.0f + s1[e]) + s0[e];
                u32x2 w; w.x = cvtpk(y[0], y[1]); w.y = cvtpk(y[2], y[3]);
                *(u32x2*)(H + (size_t)row * D + c) = w;
            }
        }
    }
}

#define XB_TMO      128
#define XB_XCNT(j)  (256  + 64 * (j))
#define XB_XSUB(j)  (1280 + 64 * (j))
#define XB_XGEN(j)  (2304 + 64 * (j))
#define XB_TOP      3328
#define XB_TOPGEN   3392
#define XCD_BAR_WORDS 3456
#define XB_SPIN_CAP (1u << 18)
__device__ __forceinline__ unsigned xb_ld(unsigned* p)              { return __hip_atomic_load(p, __ATOMIC_RELAXED, __HIP_MEMORY_SCOPE_AGENT); }
__device__ __forceinline__ unsigned xb_add(unsigned* p, unsigned v) { return __hip_atomic_fetch_add(p, v, __ATOMIC_RELAXED, __HIP_MEMORY_SCOPE_AGENT); }
__device__ __forceinline__ unsigned xb_xcc_id() { return (unsigned)__builtin_amdgcn_s_getreg((3 << 11) | 20) & 0xFu; }
#define XB_SPIN(cond, bar) do { unsigned _sp = 0; while (cond) { __builtin_amdgcn_s_sleep(1); \
    if ((++_sp & 255u) == 0u) { if (xb_ld(&(bar)[XB_TMO])) break; if (_sp > XB_SPIN_CAP) { atomicAdd(&(bar)[XB_TMO], 1u); break; } } } } while (0)
struct XcdBarrier { unsigned* bar; unsigned x; volatile LAS unsigned* st; int wid; };
__device__ __forceinline__ XcdBarrier xcd_barrier_post(unsigned* bar, volatile LAS unsigned* st, int wid) {
    XcdBarrier b; b.bar = bar; b.x = xb_xcc_id(); b.st = st; b.wid = wid;
    int t0 = wid * 64 + lane_now(); asm volatile("" : "+v"(t0));
    if (t0 == 0) (void)xb_add(&bar[XB_XCNT(b.x)], 1u);
    return b;
}
__device__ __forceinline__ void xcd_barrier_complete(unsigned* bar, unsigned x, unsigned& nloc, unsigned& nx) {
    const unsigned G = gridDim.x * gridDim.y * gridDim.z;
    unsigned sum, cnt, mine, sp = 0u;
    for (;;) {
        sum = 0u; cnt = 0u; mine = 0u;
#pragma unroll
        for (unsigned j = 0; j < 16; ++j) { const unsigned c = xb_ld(&bar[XB_XCNT(j)]); sum += c; cnt += (c > 0u) ? 1u : 0u; mine = (j == x) ? c : mine; }
        if (sum == G) break;
        __builtin_amdgcn_s_sleep(1);
        if ((++sp & 255u) == 0u) { if (xb_ld(&bar[XB_TMO])) break; if (sp > XB_SPIN_CAP) { atomicAdd(&bar[XB_TMO], 1u); break; } }
    }
    nloc = mine > 0u ? mine : 1u; nx = cnt > 0u ? cnt : 1u;
}
__device__ __forceinline__ void xcd_barrier(const XcdBarrier& b) {
    asm volatile("s_waitcnt vmcnt(0)" ::: "memory");
    __syncthreads();
    int t0 = b.wid * 64 + lane_now(); asm volatile("" : "+v"(t0));
    if (t0 == 0) {
        unsigned* bar = b.bar; unsigned bx = b.x; asm volatile("" : "+s"(bar), "+s"(bx));
        __builtin_amdgcn_s_waitcnt(0);
        unsigned nloc = b.st[0], nx = b.st[1];
        if (nloc == 0u) { xcd_barrier_complete(bar, bx, nloc, nx); b.st[0] = nloc; b.st[1] = nx; }
        const unsigned old = xb_add(&bar[XB_XSUB(bx)], 1u);
        const unsigned gen = old / nloc;
        if (old + 1u == (gen + 1u) * nloc) {
            __builtin_amdgcn_fence(__ATOMIC_RELEASE, "agent");
            asm volatile("s_waitcnt vmcnt(0)" ::: "memory");
            const unsigned og = xb_add(&bar[XB_TOP], 1u);
            const unsigned tg = og / nx;
            if (og + 1u == (tg + 1u) * nx) xb_add(&bar[XB_TOPGEN], 1u);
            else XB_SPIN(xb_ld(&bar[XB_TOPGEN]) == tg, bar);
            __builtin_amdgcn_fence(__ATOMIC_ACQUIRE, "agent");
            xb_add(&bar[XB_XGEN(bx)], 1u);
            asm volatile("s_waitcnt vmcnt(0)" ::: "memory");
        } else {
            XB_SPIN(xb_ld(&bar[XB_XGEN(bx)]) == gen, bar);
            __builtin_amdgcn_fence(__ATOMIC_ACQUIRE, "agent");
            asm volatile("s_waitcnt vmcnt(0)" ::: "memory");
        }
    }
    __syncthreads();
}

constexpr int LDS_PTRS = 131072 + 1024;
__device__ __forceinline__ const float* ldsptr(LAS unsigned char* lds, int i) {
    int off = LDS_PTRS + 8 * i; asm volatile("" : "+v"(off));
    const LAS unsigned* p = (const LAS unsigned*)(lds + off);
    const unsigned lo = __builtin_amdgcn_readfirstlane(p[0]), hi = __builtin_amdgcn_readfirstlane(p[1]);
    return (const float*)(const __attribute__((address_space(1))) float*)(((unsigned long long)hi << 32) | lo);
}
#define AIN(k) ldsptr(lds, (k))
#define PH_RELOAD do { asm volatile("" : "+s"(gw), "+s"(bid), "+s"(G), "+s"(NGW)); ws = (unsigned char*)ldsptr(lds, 29); out = (float*)ldsptr(lds, 28); modv = (float*)(ws + WS_MOD); \
    cosM = (float*)(ws + WS_COSM); sinM = (float*)(ws + WS_SINM); cosG = (float*)(ws + WS_COSG); sinG = (float*)(ws + WS_SING); \
    HO = (bf16_t*)(ws + WS_HO); P = (bf16_t*)(ws + WS_P); QM = (bf16_t*)(ws + WS_QM); KV = (bf16_t*)(ws + WS_KV); KR = (bf16_t*)(ws + WS_KR); \
    HF = (bf16_t*)(ws + WS_HF); P2 = (bf16_t*)(ws + WS_P2); KG = (bf16_t*)(ws + WS_KG); VG = (bf16_t*)(ws + WS_VG); x_prompt = AIN(0); x_sample = AIN(1); } while (0)

__global__ void __launch_bounds__(512) fwd_kernel(KArgs args) {
    extern __shared__ __attribute__((aligned(16))) unsigned char lds_raw[];
    LAS unsigned char* lds = (LAS unsigned char*)lds_raw;
    cg::grid_group grid = cg::this_grid();
    const int wid = __builtin_amdgcn_readfirstlane((int)threadIdx.x >> 6);
#define lane0 lane_now()
#define tid0 (wid * 64 + lane_now())
    int G = gridDim.x, bid = blockIdx.x;
    int gw = bid * 8 + wid, NGW = G * 8;
    unsigned char* ws = args.ws;
    float* out = args.out;
    const float* modl = nullptr;
    float* modv = (float*)(ws + WS_MOD);
    float* cosM = (float*)(ws + WS_COSM); float* sinM = (float*)(ws + WS_SINM);
    float* cosG = (float*)(ws + WS_COSG); float* sinG = (float*)(ws + WS_SING);
    bf16_t* HO = (bf16_t*)(ws + WS_HO);
    bf16_t* P = (bf16_t*)(ws + WS_P);
    bf16_t* QM = (bf16_t*)(ws + WS_QM);
    bf16_t* KV = (bf16_t*)(ws + WS_KV);
    bf16_t* KR = (bf16_t*)(ws + WS_KR);
    bf16_t* HF = (bf16_t*)(ws + WS_HF);
    bf16_t* P2 = (bf16_t*)(ws + WS_P2);
    bf16_t* KG = (bf16_t*)(ws + WS_KG);
    bf16_t* VG = (bf16_t*)(ws + WS_VG);
    const float* x_prompt = args.in[0]; const float* x_sample = args.in[1];
    int t00 = tid0; asm volatile("" : "+v"(t00));
    if (t00 == 0) {
        LAS unsigned long long* pp = (LAS unsigned long long*)(lds + LDS_PTRS);
#pragma unroll
        for (int k = 0; k < 28; ++k) pp[k] = (unsigned long long)args.in[k];
        pp[28] = (unsigned long long)args.out; pp[29] = (unsigned long long)args.ws;
    }

    if (args.ws == nullptr) grid.sync();
    if (tid0 < 2) *(volatile LAS unsigned*)(lds + 131072 + 512 + 4 * tid0) = 0u;
    __syncthreads();
    const XcdBarrier xbar = xcd_barrier_post((unsigned*)(ws + WS_BAR), (volatile LAS unsigned*)(lds + 131072 + 512), wid);
    {
        int tid = tid0; asm volatile("" : "+v"(tid)); const int lane = tid & 63;
        int tb = 0;
        tjob(args.in[15], 1024, 2080, (bf16_t*)(ws + WS_WINA), 1, tb, lds, gw, NGW, wid, lane);
        tjob(args.in[17], 256, 768, (bf16_t*)(ws + WS_WUQ), 0, tb, lds, gw, NGW, wid, lane);
        tjob(args.in[19], 256, 1024, (bf16_t*)(ws + WS_WUKV), 0, tb, lds, gw, NGW, wid, lane);
        tjob(args.in[21], 1024, 1024, (bf16_t*)(ws + WS_WOUTA), 0, tb, lds, gw, NGW, wid, lane);
        tjob(args.in[26], 1024, 2 * DFF, (bf16_t*)(ws + WS_WF1_0), 2, tb, lds, gw, NGW, wid, lane);
        tjob(args.in[27], DFF, 1024, (bf16_t*)(ws + WS_WF2_0), 0, tb, lds, gw, NGW, wid, lane);
        { u32x4* z = (u32x4*)((bf16_t*)(ws + WS_WINA) + (size_t)2080 * 1024); const int n16 = 224 * 1024 * 2 / 16;
          for (int i = bid * 512 + tid; i < n16; i += G * 512) z[i] = (u32x4){0u, 0u, 0u, 0u}; }
        for (int i = bid * 512 + tid; i < 4096 * 80; i += G * 512) {
            int t, j, pos; float ex;
            if (i < 4096 * 16) { t = i >> 4; j = i & 15; pos = (j < 8) ? (t >> 6) : (t & 63); ex = (float)(2 * (j & 7)) * (1.0f / 16.0f); }
            else { const int i2 = i - 4096 * 16; t = i2 >> 6; j = i2 & 63; pos = (j < 32) ? (t >> 6) : (t & 63); ex = (float)(2 * (j & 31)) * (1.0f / 64.0f); }
            const float x = exp2f(-ex * 13.287712379549449f), x2 = x * x;
            float cb = 1.0f + x2 * (-0.5f + x2 * (4.1666666666666664e-2f + x2 * (-1.3888888888888889e-3f + x2 * (2.4801587301587302e-5f + x2 * (-2.7557319223985888e-7f)))));
            float sb = x * (1.0f + x2 * (-1.6666666666666666e-1f + x2 * (8.3333333333333332e-3f + x2 * (-1.9841269841269841e-4f + x2 * (2.7557319223985893e-6f + x2 * (-2.5052108385441720e-8f))))));
            float rc = 1.0f, rs = 0.0f;
#pragma unroll
            for (int bb = 0; bb < 6; ++bb) {
                if (pos & (1 << bb)) { const float tt = rc * cb - rs * sb; rs = rc * sb + rs * cb; rc = tt; }
                const float t2 = cb * cb - sb * sb; sb = 2.0f * cb * sb; cb = t2;
            }
            if (i < 4096 * 16) { cosM[i] = rc; sinM[i] = rs; } else { cosG[i - 4096 * 16] = rc; sinG[i - 4096 * 16] = rs; }
        }
        for (int j = gw; j < 1024; j += NGW) {
            const size_t row = MTOK + j;
            { const f32x4 v = *(const f32x4*)(args.in[2] + (size_t)j * 256 + 4 * lane); u32x2 w; w.x = cvtpk(v[0], v[1]); w.y = cvtpk(v[2], v[3]); *(u32x2*)(P + row * LDP + 256 + 4 * lane) = w; }
#pragma unroll
            for (int q = 0; q < 2; ++q) {
                const f32x4 v = *(const f32x4*)(args.in[4] + (size_t)j * 512 + 256 * q + 4 * lane); u32x2 w; w.x = cvtpk(v[0], v[1]); w.y = cvtpk(v[2], v[3]); *(u32x2*)(P + row * LDP + 1024 + 256 * q + 4 * lane) = w;
                const f32x4 u = *(const f32x4*)(args.in[5] + (size_t)j * 512 + 256 * q + 4 * lane); u32x2 w2; w2.x = cvtpk(u[0], u[1]); w2.y = cvtpk(u[2], u[3]); *(u32x2*)(P + row * LDP + 1536 + 256 * q + 4 * lane) = w2;
            }
            if (lane < 16) { const float v0 = args.in[3][(size_t)j * 32 + 2 * lane], v1 = args.in[3][(size_t)j * 32 + 2 * lane + 1]; *(unsigned*)(KR + row * 32 + 2 * lane) = cvtpk(v0, v1); }
        }
        __syncthreads();
        if (bid < 192) {
            const int l = bid / 96, col0 = (bid % 96) * 64;
            LAS float* scond = (LAS float*)lds;
            LAS float* red = (LAS float*)(lds + 20480);
            for (int i = tid; i < 5 * 1024; i += 512) { const int gI = i >> 10, k = i & 1023; const float x = (gI < 4) ? args.in[8][gI * 1024 + k] : args.in[9][k]; scond[i] = x / (1.0f + expf(-x)); }
            __syncthreads();
            const int cq = tid & 15, kl = tid >> 4;
            f32x4 acc[5];
#pragma unroll
            for (int gI = 0; gI < 5; ++gI) acc[gI] = (f32x4){0.f, 0.f, 0.f, 0.f};
            const float* wp = args.in[10] + (size_t)l * 1024 * 6144 + col0 + 4 * cq;
#pragma unroll 2
            for (int k = kl; k < 1024; k += 32) {
                const f32x4 w = *(const f32x4*)(wp + (size_t)k * 6144);
#pragma unroll
                for (int gI = 0; gI < 5; ++gI) acc[gI] += w * scond[gI * 1024 + k];
            }
#pragma unroll
            for (int gI = 0; gI < 5; ++gI) *(LAS f32x4*)(red + (kl * 5 + gI) * 64 + 4 * cq) = acc[gI];
            __syncthreads();
            if (tid < 320) { const int gI = tid >> 6, c = tid & 63; float s = args.in[11][l * 6144 + col0 + c];
                for (int k2 = 0; k2 < 32; ++k2) s += red[(k2 * 5 + gI) * 64 + c];
                modv[(l * 5 + gI) * 6144 + col0 + c] = s; }
            __syncthreads();
        }
    }
    xcd_barrier(xbar); PH_RELOAD;

#pragma unroll
    for (int l = 0; l < 2; ++l) {
        PH_RELOAD; modl = modv + l * 5 * 6144;
        if (l == 0) norm_mod_rows(x_prompt, x_sample, AIN(12), modl, 0, 1, HO, gw, NGW, lane0);
        else norm_mod_rows(out, out + (size_t)MCTX * D, AIN(12) + 1024, modl, 0, 1, HO, gw, NGW, lane0, (G == 256) ? (const bf16_t*)(ws + WS_PART) : nullptr, out);
        xcd_barrier(xbar); PH_RELOAD; modl = modv + l * 5 * 6144;

        if (l == 0) {
            {
                pg8::Gemm g{HO, (const bf16_t*)(ws + WS_WINA), MTOK, NINA, 1024, 1024, 1024};
                pg8::StaticOrder S; S.init(MTOK, NINA, G, bid, 1024);
                pg8::EpiInA E{P, out + O_NAK, out + O_NAV, out + O_KROPE};
                if (DBG_GM & 1) pg8::gemm_phase<pg8::EpiInA, true>(lds, g, S, E, wid);
            }
            xcd_barrier(xbar); PH_RELOAD; modl = modv + l * 5 * 6144;
            int lane = lane0; asm volatile("" : "+v"(lane));
            for (int row = gw; row < MTOK; row += NGW) {
                bf16_t* pr = P + (size_t)row * LDP;
                const u32x2 a = *(const u32x2*)(pr + 4 * lane), b = *(const u32x2*)(pr + 256 + 4 * lane);
                float x[4] = {bf_lo(a.x), bf_hi(a.x), bf_lo(a.y), bf_hi(a.y)}, y[4] = {bf_lo(b.x), bf_hi(b.x), bf_lo(b.y), bf_hi(b.y)};
                const float sx = wave_sum(x[0] * x[0] + x[1] * x[1] + x[2] * x[2] + x[3] * x[3], lane);
                const float sy = wave_sum(y[0] * y[0] + y[1] * y[1] + y[2] * y[2] + y[3] * y[3], lane);
                const float rx = 1.0f / sqrtf(sx * (1.0f / 256.0f) + RMS_EPS), ry = 1.0f / sqrtf(sy * (1.0f / 256.0f) + RMS_EPS);
                const f32x4 gq = *(const f32x4*)(AIN(16) + 4 * lane), gk = *(const f32x4*)(AIN(18) + 4 * lane);
                f32x4 xn, yn;
#pragma unroll
                for (int e = 0; e < 4; ++e) { xn[e] = x[e] * rx * gq[e]; yn[e] = y[e] * ry * gk[e]; }
                u32x2 w; w.x = cvtpk(xn[0], xn[1]); w.y = cvtpk(xn[2], xn[3]); *(u32x2*)(pr + 4 * lane) = w;
                w.x = cvtpk(yn[0], yn[1]); w.y = cvtpk(yn[2], yn[3]); *(u32x2*)(pr + 256 + 4 * lane) = w;
                if (row < MCTX) *(f32x4*)(out + O_CKV + (size_t)row * 256 + 4 * lane) = yn;
                if (lane < 16) {
                    float x1 = __uint_as_float((unsigned)pr[2048 + lane] << 16), x2 = __uint_as_float((unsigned)pr[2064 + lane] << 16);
                    if (row >= MCTX) { const int t = (row - MCTX) & 4095; const float c = cosM[t * 16 + lane], s = sinM[t * 16 + lane];
                        const float n1 = x1 * c - x2 * s, n2 = x1 * s + x2 * c; x1 = n1; x2 = n2; }
                    KR[(size_t)row * 32 + lane] = (bf16_t)(cvtpk(x1, 0.f) & 0xffffu); KR[(size_t)row * 32 + 16 + lane] = (bf16_t)(cvtpk(x2, 0.f) & 0xffffu);
                }
            }
            xcd_barrier(xbar); PH_RELOAD; modl = modv + l * 5 * 6144;
            {
                pg8::Gemm g{P, (const bf16_t*)(ws + WS_WUQ), MTOK, 768, 256, LDP, 256};
                pg8::StaticOrder S; S.init(g.M, g.N, G, bid, 256);
                pg8::EpiStore E{QM, 768};
                if (DBG_GM & 2) pg8::gemm_phase<pg8::EpiStore, true>(lds, g, S, E, wid);
            }
            {
                pg8::Gemm g{P + 256, (const bf16_t*)(ws + WS_WUKV), MALL, 1024, 256, LDP, 256};
                pg8::StaticOrder S; S.init(g.M, g.N, G, bid, 256);
                pg8::EpiStore E{KV, 1024};
                if (DBG_GM & 2) pg8::gemm_phase<pg8::EpiStore, true>(lds, g, S, E, wid);
            }
            xcd_barrier(xbar); PH_RELOAD; modl = modv + l * 5 * 6144;
            {
                bf16_t* O = HO;
                const float mla_sc = 0.10206207261596575f * LOG2E, na_sc = 0.125f * LOG2E;
                int bidl = bid; asm volatile("" : "+s"(bidl));
                const bool xmap = (G == 256); const int xcd = bidl & 7, jb = bidl >> 3;
                for (int u0 = bidl; u0 < 1280; u0 += G) {
                    int u = u0;
                    if (xmap && ((bidl >> 3) & 1) && u0 < 1024) u = u0 ^ 512;
                    AttnArgs a{};
                    a.O = nullptr;
                    if (u < 512) {
                        const int v = jb + 32 * (u >> 8), b = xmap ? (xcd >> 1) : (u >> 7), h = xmap ? ((xcd & 1) * 4 + (v >> 4)) : ((u >> 4) & 7), qb = xmap ? (v & 15) : (u & 15);
                        a.Q = QM + h * 96; a.ldq = 768; a.Ka = KV + h * 128; a.ldka = 1024; a.Kb = KR; a.ldkb = 32; a.V = KV + h * 128 + 64; a.ldv = 1024;
                        a.O = O + h * 64; a.ldo = 1024; a.qrow0 = MCTX + b * 4096 + qb * 256; a.seg0row = MCTX + b * 4096; a.seg0n = 4096; a.seg1row = MTOK + b * 256; a.seg1n = 256;
                        a.scale_log2 = mla_sc; a.rope = 1; a.tpos0 = qb * 256; a.cosT = cosM; a.sinT = sinM;
                        attn_unit<96, 64, 8, 1, false>(lds, a, wid);
                    } else if (u < 1024) {
                        const int w = u - 512, v = jb + 32 * (w >> 8), b = xmap ? (xcd >> 1) : (w >> 7), h = xmap ? ((xcd & 1) * 4 + (v >> 4)) : ((w >> 4) & 7), qb = xmap ? (v & 15) : (w & 15), r0 = 4 * qb;
                        const int rsmin = min(max(r0 - 4, 0), 56), rsmax = min(max(r0 + 3 - 4, 0), 56), nb = rsmax + 8 - rsmin;
                        a.Q = P + 512 + h * 64; a.ldq = LDP; a.Ka = P + 1024 + h * 64; a.ldka = LDP; a.Kb = a.Ka; a.ldkb = LDP; a.V = P + 1536 + h * 64; a.ldv = LDP;
                        a.O = O + 512 + h * 64; a.ldo = 1024; a.qrow0 = MCTX + b * 4096 + qb * 256; a.seg0row = MTOK + b * 256; a.seg0n = 256; a.seg1row = MCTX + b * 4096 + rsmin * 64; a.seg1n = nb * 64;
                        a.scale_log2 = na_sc; a.rpb = AIN(20) + h * 465; a.r0 = r0; a.rsmin = rsmin;
                        attn_unit<64, 64, 8, 0, true>(lds, a, wid);
                    } else if (u < 1152) {
                        const int v = u - 1024, b = v >> 3, h = v & 7;
                        a.Q = QM + h * 96; a.ldq = 768; a.Ka = KV + h * 128; a.ldka = 1024; a.Kb = KR; a.ldkb = 32; a.V = KV + h * 128 + 64; a.ldv = 1024;
                        a.O = O + h * 64; a.ldo = 1024; a.qrow0 = b * 256; a.seg0row = b * 256; a.seg0n = 256; a.seg1row = 0; a.seg1n = 0;
                        a.scale_log2 = mla_sc; a.rope = 0; a.tpos0 = 0; a.cosT = cosM; a.sinT = sinM;
                        attn_unit<96, 64, 8, 1, false>(lds, a, wid);
                    } else {
                        const int v = u - 1152, b = v >> 3, h = v & 7;
                        a.Q = P + 512 + h * 64; a.ldq = LDP; a.Ka = P + 1024 + h * 64; a.ldka = LDP; a.Kb = a.Ka; a.ldkb = LDP; a.V = P + 1536 + h * 64; a.ldv = LDP;
                        a.O = O + 512 + h * 64; a.ldo = 1024; a.qrow0 = b * 256; a.seg0row = b * 256; a.seg0n = 256; a.seg1row = 0; a.seg1n = 0;
                        a.scale_log2 = na_sc;
                        attn_unit<64, 64, 8, 0, false>(lds, a, wid);
                    }
                }
            }
            xcd_barrier(xbar); PH_RELOAD; modl = modv + l * 5 * 6144;
        } else {
            {
                pg8::Gemm g{HO, (const bf16_t*)(ws + WS_WINC), MTOK, NINC, 1024, 1024, 1024};
                pg8::StaticOrder S; S.init(MTOK, NINC, G, bid, 1024);
                pg8::EpiInC E{P2, out + O_GV};
                if (DBG_GM & 4) pg8::gemm_phase<pg8::EpiInC, true>(lds, g, S, E, wid);
            }
            xcd_barrier(xbar); PH_RELOAD; modl = modv + l * 5 * 6144;
            int lane = lane0; asm volatile("" : "+v"(lane));
            for (int row = gw; row < MALL; row += NGW) {
                if (row < MTOK) {
                    const bf16_t* pr = P2 + (size_t)row * NINC;
#pragma unroll
                    for (int kvh = 0; kvh < 2; ++kvh) {
                        const float x1 = __uint_as_float((unsigned)pr[1024 + kvh * 128 + lane] << 16), x2 = __uint_as_float((unsigned)pr[1024 + kvh * 128 + 64 + lane] << 16);
                        const float ss = wave_sum(x1 * x1 + x2 * x2, lane);
                        const float rstd = 1.0f / sqrtf(ss * (1.0f / 128.0f) + RMS_EPS);
                        float k1 = x1 * rstd * AIN(24)[lane], k2 = x2 * rstd * AIN(24)[64 + lane];
                        if (row < MCTX) { out[O_GK + (size_t)row * 256 + kvh * 128 + lane] = k1; out[O_GK + (size_t)row * 256 + kvh * 128 + 64 + lane] = k2; }
                        else { const int t = (row - MCTX) & 4095; const float c = cosG[t * 64 + lane], s = sinG[t * 64 + lane];
                            const float n1 = k1 * c - k2 * s, n2 = k1 * s + k2 * c; k1 = n1; k2 = n2; }
                        KG[(size_t)row * 256 + kvh * 128 + lane] = (bf16_t)(cvtpk(k1, 0.f) & 0xffffu); KG[(size_t)row * 256 + kvh * 128 + 64 + lane] = (bf16_t)(cvtpk(k2, 0.f) & 0xffffu);
                    }
                    *(u32x2*)(VG + (size_t)row * 256 + 4 * lane) = *(const u32x2*)(pr + 1280 + 4 * lane);
                } else {
                    const int j = row - MTOK;
                    const f32x4 kk = *(const f32x4*)(AIN(6) + (size_t)j * 256 + 4 * lane), vv = *(const f32x4*)(AIN(7) + (size_t)j * 256 + 4 * lane);
                    u32x2 w; w.x = cvtpk(kk[0], kk[1]); w.y = cvtpk(kk[2], kk[3]); *(u32x2*)(KG + (size_t)row * 256 + 4 * lane) = w;
                    w.x = cvtpk(vv[0], vv[1]); w.y = cvtpk(vv[2], vv[3]); *(u32x2*)(VG + (size_t)row * 256 + 4 * lane) = w;
                }
            }
            xcd_barrier(xbar); PH_RELOAD; modl = modv + l * 5 * 6144;
            {
                bf16_t* O = HO;
                const float sc = 0.08838834764831845f * LOG2E;
                int bidl = bid; asm volatile("" : "+s"(bidl));
                const bool xmap = (G == 256);
                for (int u = bidl; u < 640; u += G) {
                    AttnArgs a{};
                    int h;
                    if (u < 512) { const int v = (bidl >> 3) + 32 * (u >> 8), b = xmap ? ((bidl & 7) >> 1) : (u >> 7), qb = xmap ? (v & 15) : (u & 15); h = xmap ? ((bidl & 1) * 4 + (v >> 4)) : ((u >> 4) & 7);
                        a.qrow0 = MCTX + b * 4096 + qb * 256; a.seg0row = MCTX + b * 4096; a.seg0n = 4096; a.seg1row = MTOK + b * 256; a.seg1n = 256; a.rope = 1; a.tpos0 = qb * 256;
                    } else { const int v = u - 512, b = v >> 3; h = v & 7;
                        a.qrow0 = b * 256; a.seg0row = b * 256; a.seg0n = 256; a.seg1row = 0; a.seg1n = 0; a.rope = 0; a.tpos0 = 0; }
                    a.Q = P2 + h * 128; a.ldq = NINC; a.Ka = KG + (h >> 2) * 128; a.ldka = 256; a.Kb = a.Ka; a.ldkb = 256; a.V = VG + (h >> 2) * 128; a.ldv = 256;
                    a.O = O + h * 128; a.ldo = 1024; a.scale_log2 = sc; a.cosT = cosG; a.sinT = sinG; a.qnorm = AIN(23);
                    attn_unit<128, 128, 16, 2, false>(lds, a, wid);
                }
            }
            xcd_barrier(xbar); PH_RELOAD; modl = modv + l * 5 * 6144;
        }
        {
            pg8::Gemm g{HO, (const bf16_t*)(ws + (l == 0 ? WS_WOUTA : WS_WOUTC)), MTOK, 1024, 1024, 1024, 1024};
            pg8::StaticOrder S; S.init(MTOK, 1024, G, bid, 1024, (G == 256) ? 1 : 0);
            pg8::EpiRes E{l == 0 ? x_prompt : out, l == 0 ? x_sample : out + (size_t)MCTX * D, out, modl + 2 * 1024, (bf16_t*)(ws + WS_PART)};
            if (DBG_GM & 8) pg8::gemm_phase<pg8::EpiRes, true>(lds, g, S, E, wid);
        }
        xcd_barrier(xbar); PH_RELOAD; modl = modv + l * 5 * 6144;
        norm_mod_rows(out, out + (size_t)MCTX * D, AIN(13) + l * 1024, modl, 3, 4, HO, gw, NGW, lane0, (G == 256) ? (const bf16_t*)(ws + WS_PART) : nullptr, out, (l == 0 && G == 256) ? x_sample + (size_t)(16384 - MCTX) * D : nullptr);
        if (l == 0) {
            int tb = 0;
            tjob(AIN(22), 1024, NINC, (bf16_t*)(ws + WS_WINC), 0, tb, lds, gw, NGW, wid, lane0);
            tjob(AIN(25), 1024, 1024, (bf16_t*)(ws + WS_WOUTC), 0, tb, lds, gw, NGW, wid, lane0);
            tjob(AIN(26) + (size_t)1024 * 2 * DFF, 1024, 2 * DFF, (bf16_t*)(ws + WS_WF1_1), 2, tb, lds, gw, NGW, wid, lane0);
            tjob(AIN(27) + (size_t)DFF * 1024, DFF, 1024, (bf16_t*)(ws + WS_WF2_1), 0, tb, lds, gw, NGW, wid, lane0);
        }
        xcd_barrier(xbar); PH_RELOAD; modl = modv + l * 5 * 6144;
        {
            pg8::Gemm g{HO, (const bf16_t*)(ws + (l == 0 ? WS_WF1_0 : WS_WF1_1)), MTOK, 2 * DFF, 1024, 1024, 1024};
            pg8::StaticOrder S; S.init(MTOK, 2 * DFF, G, bid, 1024);
            pg8::EpiSwiglu E{HF};
            if (DBG_GM & 16) pg8::gemm_phase<pg8::EpiSwiglu, true>(lds, g, S, E, wid);
        }
        xcd_barrier(xbar); PH_RELOAD; modl = modv + l * 5 * 6144;
        {
            pg8::Gemm g{HF, (const bf16_t*)(ws + (l == 0 ? WS_WF2_0 : WS_WF2_1)), MTOK, 1024, DFF, DFF, DFF};
            pg8::StaticOrder S; S.init(MTOK, 1024, G, bid, DFF, (G == 256) ? 1 : 0);
            pg8::EpiRes E{out, out + (size_t)MCTX * D, out, modl + 5 * 1024, (bf16_t*)(ws + WS_PART)};
            if (DBG_GM & 32) pg8::gemm_phase<pg8::EpiRes, true>(lds, g, S, E, wid);
        }
        xcd_barrier(xbar); PH_RELOAD; modl = modv + l * 5 * 6144;
    }
    PH_RELOAD;
    int lane = lane0; asm volatile("" : "+v"(lane));
    for (int row = gw; row < MTOK; row += NGW) {
        float* xr = out + (size_t)row * D;
        f32x4 v[4]; float s = 0.f;
#pragma unroll
        for (int j = 0; j < 4; ++j) v[j] = *(const f32x4*)(xr + 4 * lane + 256 * j);
        if (G == 256 && row >= 16384) {
            const bf16_t* part = (const bf16_t*)(ws + WS_PART);
#pragma unroll
            for (int p = 0; p < 4; ++p)
#pragma unroll
                for (int j = 0; j < 4; ++j) { const u32x2 w = *(const u32x2*)(part + ((size_t)p * 4096 + (row - 16384)) * 1024 + 4 * lane + 256 * j);
                    v[j][0] += bf_lo(w.x); v[j][1] += bf_hi(w.x); v[j][2] += bf_lo(w.y); v[j][3] += bf_hi(w.y); }
        }
#pragma unroll
        for (int j = 0; j < 4; ++j) s += v[j][0] * v[j][0] + v[j][1] * v[j][1] + v[j][2] * v[j][2] + v[j][3] * v[j][3];
        const float rstd = 1.0f / sqrtf(wave_sum(s, lane) * (1.0f / D) + RMS_EPS);
#pragma unroll
        for (int j = 0; j < 4; ++j) { const f32x4 gg = *(const f32x4*)(AIN(14) + 4 * lane + 256 * j); *(f32x4*)(xr + 4 * lane + 256 * j) = v[j] * rstd * gg; }
    }
}

extern "C" void kernel_launch(void* const* d_in, const int* in_sizes, int n_in, void* d_out, int out_size, void* d_ws, size_t ws_size, hipStream_t stream) {
    static int grid_blocks = 0;
    if (grid_blocks == 0) {
        if (n_in != 28 || ws_size < WS_END0) { fprintf(stderr, "kernel_launch: unexpected n_in %d / ws_size %zu\n", n_in, ws_size); grid_blocks = -1; return; }
        int dev = 0, cus = 0, per_cu = 0;
        hipGetDevice(&dev);
        hipDeviceGetAttribute(&cus, hipDeviceAttributeMultiprocessorCount, dev);
        hipFuncSetAttribute((const void*)fwd_kernel, hipFuncAttributeMaxDynamicSharedMemorySize, LDS_BYTES);
        hipOccupancyMaxActiveBlocksPerMultiprocessor(&per_cu, (const void*)fwd_kernel, 512, LDS_BYTES);
        (void)hipGetLastError();
        if (per_cu < 1) per_cu = 1;
        grid_blocks = cus * 1;
        if (grid_blocks > 256) grid_blocks = 256;
    }
    if (grid_blocks < 0) return;
    if (hipMemsetAsync((char*)d_ws + WS_BAR, 0, XCD_BAR_WORDS * 4, stream) != hipSuccess) { fprintf(stderr, "kernel_launch: memset of barrier words failed\n"); return; }
    KArgs a{};
    for (int i = 0; i < 28; ++i) a.in[i] = (const float*)d_in[i];
    a.out = (float*)d_out; a.ws = (unsigned char*)d_ws;
    void* kargs[] = {&a};
    hipError_t e = hipLaunchCooperativeKernel((const void*)fwd_kernel, dim3(grid_blocks), dim3(512), kargs, LDS_BYTES, stream);
    if (e != hipSuccess) fprintf(stderr, "cooperative launch failed: %s (grid %d)\n", hipGetErrorString(e), grid_blocks);
}
```
